# Optimizing an MI355X kernel written in HIP

```python
import math
import jax, jax.numpy as jnp
from jax import lax
import numpy as np

D_MODEL = 1024
BATCH = 8
SEQ = 4096
DEPTH = 2

N_A = (DEPTH + 1) // 2
N_B = DEPTH - N_A

GLA_HEADS = 4
QK_DIM = D_MODEL // 2
V_DIM = D_MODEL
DK = QK_DIM // GLA_HEADS
DV = V_DIM // GLA_HEADS
GATE_RANK = 16
GATE_NORMALIZER = 16.0
CHUNK = 64
A_IN_DIM = 2 * QK_DIM + V_DIM + GATE_RANK + V_DIM

SB_HEADS = 16
SB_HEAD_DIM = D_MODEL // SB_HEADS
SB_DIM = SB_HEADS * SB_HEAD_DIM
Q_BLOCK = 128

N_GROUPS = 4
EXPERTS_PER_GROUP = 4
N_EXPERTS = N_GROUPS * EXPERTS_PER_GROUP
TOP_K = 2
D_EXPERT = D_MODEL // 2

RMS_EPS = 1e-6

kernel_name = "yoco_gla_stickbreaking_hmoe"


def rms_norm(x, g):
    xf = x.astype(jnp.float32)
    y = xf * lax.rsqrt(jnp.mean(xf * xf, axis=-1, keepdims=True) + RMS_EPS)
    return (y * g.astype(jnp.float32)).astype(x.dtype)


def gla_mixer(u, w_in, w_gk2, b_gk2, o_norm, w_out):
    B, S, _ = u.shape
    n = S // CHUNK
    proj = u @ w_in
    q, k, v, gk_lr, g = jnp.split(
        proj, [QK_DIM, 2 * QK_DIM, 2 * QK_DIM + V_DIM, 2 * QK_DIM + V_DIM + GATE_RANK], axis=-1)
    gk = jax.nn.log_sigmoid((gk_lr @ w_gk2 + b_gk2).astype(jnp.float32)) / GATE_NORMALIZER

    def to_chunks(t, dh):
        return t.reshape(B, n, CHUNK, GLA_HEADS, dh).transpose(0, 3, 1, 2, 4).astype(jnp.float32)

    q = to_chunks(q, DK) * (DK ** -0.5)
    k = to_chunks(k, DK)
    v = to_chunks(v, DV)
    gk = to_chunks(gk, DK)
    b = jnp.cumsum(gk, axis=3)
    q_dec = q * jnp.exp(b)
    k_inv = k * jnp.exp(-b)

    causal = jnp.tril(jnp.ones((CHUNK, CHUNK), dtype=bool))
    att = jnp.where(causal, jnp.einsum('bhnid,bhnjd->bhnij', q_dec, k_inv), 0.0)
    o_intra = jnp.einsum('bhnij,bhnje->bhnie', att, v)

    b_last = b[:, :, :, -1, :]
    k_to_end = k * jnp.exp(b_last[:, :, :, None, :] - b)
    upd = jnp.einsum('bhncd,bhnce->bhnde', k_to_end, v)

    def step(state, inp):
        dec, u_n = inp
        return dec[..., None] * state + u_n, state

    init = jnp.zeros((B, GLA_HEADS, DK, DV), jnp.float32)
    _, prev = lax.scan(step, init, (jnp.moveaxis(jnp.exp(b_last), 2, 0), jnp.moveaxis(upd, 2, 0)))
    prev = jnp.moveaxis(prev, 0, 2)
    o = o_intra + jnp.einsum('bhncd,bhnde->bhnce', q_dec, prev)

    o = rms_norm(o, o_norm)
    o = o.transpose(0, 2, 3, 1, 4).reshape(B, S, V_DIM)
    o = o * jax.nn.silu(g.astype(jnp.float32))
    return o.astype(u.dtype) @ w_out


def stick_breaking_attention(q, k, v):
    S = q.shape[2]
    scale = 1.0 / math.sqrt(SB_HEAD_DIM)
    outs = []
    for blk in range(S // Q_BLOCK):
        t0 = blk * Q_BLOCK
        L = t0 + Q_BLOCK
        qb = q[:, :, t0:L].astype(jnp.float32)
        kb = k[:, :, :L].astype(jnp.float32)
        vb = v[:, :, :L].astype(jnp.float32)
        z = jnp.einsum('bhtd,bhsd->bhts', qb, kb) * scale
        tpos = t0 + jnp.arange(Q_BLOCK)
        spos = jnp.arange(L)
        mask = spos[None, :] < tpos[:, None]
        log_om = jnp.where(mask, jax.nn.log_sigmoid(-z), 0.0)
        log_beta = jax.nn.log_sigmoid(z)
        suffix = lax.cumsum(log_om, axis=3, reverse=True) - log_om
        a = jnp.where(mask, jnp.exp(log_beta + suffix), 0.0)
        outs.append(jnp.einsum('bhts,bhsd->bhtd', a, vb))
    return jnp.concatenate(outs, axis=2)


def stick_breaking_mixer(u, k, v, w_q, w_out):
    B, S, _ = u.shape
    q = (u @ w_q).reshape(B, S, SB_HEADS, SB_HEAD_DIM).transpose(0, 2, 1, 3)
    o = stick_breaking_attention(q, k, v)
    o = o.transpose(0, 2, 1, 3).reshape(B, S, SB_DIM).astype(u.dtype)
    return o @ w_out


def hier_moe(t, w_group, b_group, w_expert, b_expert, w_gate, w_up, w_down):
    T = t.shape[0]
    g_logits = (t @ w_group + b_group).astype(jnp.float32)
    g_prob = jax.nn.softmax(g_logits, axis=-1)
    g_w, g_idx = lax.top_k(g_prob, 1)
    e_logits = (t @ w_expert + b_expert).astype(jnp.float32).reshape(T, N_GROUPS, EXPERTS_PER_GROUP)
    e_sel = jnp.take_along_axis(e_logits, g_idx[:, :, None], axis=1)[:, 0]
    e_prob = jax.nn.softmax(e_sel, axis=-1)
    e_w, e_idx = lax.top_k(e_prob, TOP_K)
    e_w = e_w / jnp.sum(e_w, axis=-1, keepdims=True)
    weights = g_w * e_w
    global_idx = g_idx * EXPERTS_PER_GROUP + e_idx
    combine = jnp.einsum('tk,tke->te', weights, jax.nn.one_hot(global_idx, N_EXPERTS, dtype=jnp.float32))
    y = jnp.zeros(t.shape, jnp.float32)
    for e in range(N_EXPERTS):
        hdn = jax.nn.silu(t @ w_gate[e]) * (t @ w_up[e])
        y = y + combine[:, e:e + 1] * (hdn @ w_down[e]).astype(jnp.float32)
    return y.astype(t.dtype)


def setup_inputs(seed: int = 0) -> dict:
    key = jax.random.key(seed)
    ks = iter(jax.random.split(key, 32))
    f32 = jnp.float32

    def nrm(shape, scale):
        return jax.random.normal(next(ks), shape, f32) * scale

    def gain(shape):
        return 1.0 + 0.01 * jax.random.normal(next(ks), shape, f32)

    D = D_MODEL
    return {
        "x": jax.random.normal(next(ks), (BATCH, SEQ, D), f32),
        "a_norm": gain((N_A, D)),
        "a_w_in": nrm((N_A, D, A_IN_DIM), D ** -0.5),
        "a_w_gk2": nrm((N_A, GATE_RANK, QK_DIM), GATE_RANK ** -0.5),
        "a_b_gk2": nrm((N_A, QK_DIM), 0.01),
        "a_o_norm": gain((N_A, DV)),
        "a_w_out": nrm((N_A, V_DIM, D), V_DIM ** -0.5),
        "kv_norm": gain((D,)),
        "w_kv": nrm((D, 2 * SB_DIM), D ** -0.5),
        "b_norm": gain((N_B, D)),
        "b_w_q": nrm((N_B, D, SB_DIM), D ** -0.5),
        "b_w_out": nrm((N_B, SB_DIM, D), SB_DIM ** -0.5),
        "m_norm": gain((DEPTH, D)),
        "m_w_group": nrm((DEPTH, D, N_GROUPS), D ** -0.5),
        "m_b_group": nrm((DEPTH, N_GROUPS), 0.01),
        "m_w_expert": nrm((DEPTH, D, N_EXPERTS), D ** -0.5),
        "m_b_expert": nrm((DEPTH, N_EXPERTS), 0.01),
        "m_w_gate": nrm((DEPTH, N_EXPERTS, D, D_EXPERT), D ** -0.5),
        "m_w_up": nrm((DEPTH, N_EXPERTS, D, D_EXPERT), D ** -0.5),
        "m_w_down": nrm((DEPTH, N_EXPERTS, D_EXPERT, D), D_EXPERT ** -0.5),
        "final_norm": gain((D,)),
    }


def reference(x, a_norm, a_w_in, a_w_gk2, a_b_gk2, a_o_norm, a_w_out, kv_norm, w_kv,
              b_norm, b_w_q, b_w_out, m_norm, m_w_group, m_b_group, m_w_expert, m_b_expert,
              m_w_gate, m_w_up, m_w_down, final_norm):
    B, S, D = x.shape
    h = x
    k_shared = None
    v_shared = None
    for layer in range(DEPTH):
        if layer < N_A:
            h = h + gla_mixer(rms_norm(h, a_norm[layer]), a_w_in[layer], a_w_gk2[layer],
                              a_b_gk2[layer], a_o_norm[layer], a_w_out[layer])
        else:
            if layer == N_A:
                kv = rms_norm(h, kv_norm) @ w_kv
                k_s, v_s = jnp.split(kv, 2, axis=-1)
                k_shared = k_s.reshape(B, S, SB_HEADS, SB_HEAD_DIM).transpose(0, 2, 1, 3)
                v_shared = v_s.reshape(B, S, SB_HEADS, SB_HEAD_DIM).transpose(0, 2, 1, 3)
            j = layer - N_A
            h = h + stick_breaking_mixer(rms_norm(h, b_norm[j]), k_shared, v_shared, b_w_q[j], b_w_out[j])
        t = rms_norm(h, m_norm[layer]).reshape(B * S, D)
        h = h + hier_moe(t, m_w_group[layer], m_b_group[layer], m_w_expert[layer], m_b_expert[layer],
                         m_w_gate[layer], m_w_up[layer], m_w_down[layer]).reshape(B, S, D)
    return rms_norm(h, final_norm)
```

```cpp
#include <hip/hip_runtime.h>
#include <cstdio>
#include <cstdint>
__device__ __forceinline__ int tidx_opaque() { int t = (int)threadIdx.x; asm volatile("" : "+v"(t)); return t; }
#define TIDX tidx_opaque()
namespace pg8 {
#define PG8_LAS __attribute__((address_space(3)))
typedef unsigned short bf16_t;
typedef short bf16x8 __attribute__((ext_vector_type(8)));
typedef float f32x4 __attribute__((ext_vector_type(4)));
typedef unsigned u32x4 __attribute__((ext_vector_type(4)));
constexpr int BM = 256, BK = 64, HALF = 128, HTB = HALF * BK * 2  , STAGE_BYTES = 8 * HTB, NXCD = 8, WGM = 8;

__host__ __device__ __forceinline__ int lds_byte(int r, int c) { const int st = (r >> 4) * 2 + (c >> 5), rr = r & 15, cc = c & 31, ob = rr * 64 + cc * 2; return st * 1024 + (ob ^ (((ob >> 9) & 1) << 5)); }
__host__ __device__ __forceinline__ void stage_rc(int b, int& R, int& C) { const int st = b / 1024, sb = b % 1024, swz = sb ^ (((sb >> 9) & 1) << 5); R = (st >> 1) * 16 + swz / 64; C = (st & 1) * 32 + (swz % 64) / 2; }
__host__ __device__ __forceinline__ int perm32(int rho) { const int n = rho >> 4, i = rho & 15; return 8 * (i >> 2) + 4 * n + (i & 3); }

struct Unit { int pm, pn; };
struct Gemm { const bf16_t* A; const bf16_t* Bt; int M, N, K; };

struct StaticOrder {
    int nM, nN, nwg, G, c;
    __host__ __device__ void init(int M, int N, int G_, int c_) { nM = M / BM; nN = N / BM; nwg = nM * nN; G = G_; c = c_; }
    __host__ __device__ bool next(int i, Unit& u) const {
        const long L = (long)i * G + c; if (L >= nwg) return false;
        int wgid = (int)L; { const int q = nwg / NXCD, r = nwg % NXCD, xcd = wgid % NXCD, off = wgid / NXCD; wgid = (xcd < r ? xcd * (q + 1) : r * (q + 1) + (xcd - r) * q) + off; }
        const int nig = WGM * nN, gid = wgid / nig, fm = gid * WGM, gsz = (nM - fm) < WGM ? (nM - fm) : WGM;
        u.pm = fm + ((wgid % nig) % gsz); u.pn = (wgid % nig) / gsz; return true;
    }
    __device__ __forceinline__ void a_ready(const Unit&) const {}
    __device__ __forceinline__ void done(const Unit&) const {}
};

typedef int v4i_t __attribute__((ext_vector_type(4)));
typedef int v8i_t __attribute__((ext_vector_type(8)));
__device__ __forceinline__ v8i_t cat8(bf16x8 a, bf16x8 b) { const v4i_t x = __builtin_bit_cast(v4i_t, a), y = __builtin_bit_cast(v4i_t, b); return __builtin_shufflevector(x, y, 0, 1, 2, 3, 4, 5, 6, 7); }
__device__ __forceinline__ float clamp8(float x) { return fminf(fmaxf(x, -448.f), 448.f); }
__device__ __forceinline__ unsigned pk_fp8x4(float a, float b, float c, float d) { int p = __builtin_amdgcn_cvt_pk_fp8_f32(clamp8(a), clamp8(b), 0, false); p = __builtin_amdgcn_cvt_pk_fp8_f32(clamp8(c), clamp8(d), p, true); return (unsigned)p; }
__device__ __forceinline__ unsigned pk_fp8x4_nc(float a, float b, float c, float d) { int p = __builtin_amdgcn_cvt_pk_fp8_f32(a, b, 0, false); p = __builtin_amdgcn_cvt_pk_fp8_f32(c, d, p, true); return (unsigned)p; }
__device__ __forceinline__ unsigned cvt_pk_bf16(float lo, float hi) { unsigned r; asm volatile("v_cvt_pk_bf16_f32 %0, %1, %2" : "=v"(r) : "v"(lo), "v"(hi)); return r; }
struct EpiBf16Plain {
    static constexpr bool PERM = true, AFTER_DRAIN = false, ROWSCALE = false;
    bf16_t* O; int ldc; int nct;
    __device__ __forceinline__ void operator()(const f32x4 (&acc)[2][2][4][2], const Unit& u, int wr, int wc, int fr, int fq) const {
        const int row0 = u.pm * BM + wr * 64 + fr; const int col0 = (u.pn % nct) * BM + wc * 32 + 8 * fq;
#pragma unroll
        for (int ai = 0; ai < 2; ++ai)
#pragma unroll
            for (int m = 0; m < 4; ++m) { bf16_t* rowp = O + (size_t)(row0 + ai * HALF + m * 16) * ldc + col0;
#pragma unroll
                for (int bj = 0; bj < 2; ++bj) { const f32x4 v0 = acc[ai][bj][m][0], v1 = acc[ai][bj][m][1];
                    u32x4 w; w.x = cvt_pk_bf16(v0[0], v0[1]); w.y = cvt_pk_bf16(v0[2], v0[3]); w.z = cvt_pk_bf16(v1[0], v1[1]); w.w = cvt_pk_bf16(v1[2], v1[3]);
                    *(u32x4*)(rowp + bj * HALF) = w; } }
    }
};
struct EpiScaleRows {
    static constexpr bool PERM = true, AFTER_DRAIN = false, ROWSCALE = true;
    bf16_t* O; int ldc; int nct; const float* rs; const PG8_LAS float* rsl;
    __device__ __forceinline__ void operator()(const f32x4 (&acc)[2][2][4][2], const Unit& u, int wr, int wc, int fr, int fq) const {
        const int row0 = u.pm * BM + wr * 64 + fr; const int col0 = (u.pn % nct) * BM + wc * 32 + 8 * fq;
#pragma unroll
        for (int ai = 0; ai < 2; ++ai)
#pragma unroll
            for (int m = 0; m < 4; ++m) { const int row = row0 + ai * HALF + m * 16; const float s = rsl[wr * 64 + fr + ai * HALF + m * 16]; bf16_t* rowp = O + (size_t)row * ldc + col0;
#pragma unroll
                for (int bj = 0; bj < 2; ++bj) { const f32x4 v0 = acc[ai][bj][m][0] * s, v1 = acc[ai][bj][m][1] * s;
                    u32x4 w; w.x = cvt_pk_bf16(v0[0], v0[1]); w.y = cvt_pk_bf16(v0[2], v0[3]); w.z = cvt_pk_bf16(v1[0], v1[1]); w.w = cvt_pk_bf16(v1[2], v1[3]);
                    *(u32x4*)(rowp + bj * HALF) = w; } }
    }
};
struct EpiScaleRows8 {
    static constexpr bool PERM = true, AFTER_DRAIN = false, ROWSCALE = true;
    unsigned char* O; int ldc; int nct; const float* rs; const PG8_LAS float* rsl;
    __device__ __forceinline__ void operator()(const f32x4 (&acc)[2][2][4][2], const Unit& u, int wr, int wc, int fr, int fq) const {
        const int row0 = u.pm * BM + wr * 64 + fr; const int col0 = (u.pn % nct) * BM + wc * 32 + 8 * fq;
        typedef unsigned u32x2 __attribute__((ext_vector_type(2)));
#pragma unroll
        for (int ai = 0; ai < 2; ++ai)
#pragma unroll
            for (int m = 0; m < 4; ++m) { const int row = row0 + ai * HALF + m * 16; const float s = rsl[wr * 64 + fr + ai * HALF + m * 16] * 16.f; unsigned char* rowp = O + (size_t)row * ldc + col0;
#pragma unroll
                for (int bj = 0; bj < 2; ++bj) { const f32x4 v0 = acc[ai][bj][m][0] * s, v1 = acc[ai][bj][m][1] * s;
                    u32x2 w; w.x = pk_fp8x4(v0[0], v0[1], v0[2], v0[3]); w.y = pk_fp8x4(v1[0], v1[1], v1[2], v1[3]);
                    *(u32x2*)(rowp + bj * HALF) = w; } }
    }
};
__device__ __forceinline__ float silu_f(float g) { return g * __builtin_amdgcn_rcpf(1.f + __expf(-g)); }
struct EpiSwiGLU {
    static constexpr bool PERM = true, AFTER_DRAIN = false, ROWSCALE = false;
    bf16_t* O; int ldc; int nct;
    __device__ __forceinline__ void operator()(const f32x4 (&acc)[2][2][4][2], const Unit& u, int wr, int wc, int fr, int fq) const {
        const int row0 = u.pm * BM + wr * 64 + fr; const int col0 = (u.pn % nct) * HALF + wc * 32 + 8 * fq;
#pragma unroll
        for (int ai = 0; ai < 2; ++ai)
#pragma unroll
            for (int m = 0; m < 4; ++m) { bf16_t* rowp = O + (size_t)(row0 + ai * HALF + m * 16) * ldc + col0;
                const f32x4 g0 = acc[ai][0][m][0], g1 = acc[ai][0][m][1], u0 = acc[ai][1][m][0], u1 = acc[ai][1][m][1];
                u32x4 w; w.x = cvt_pk_bf16(silu_f(g0[0]) * u0[0], silu_f(g0[1]) * u0[1]); w.y = cvt_pk_bf16(silu_f(g0[2]) * u0[2], silu_f(g0[3]) * u0[3]);
                w.z = cvt_pk_bf16(silu_f(g1[0]) * u1[0], silu_f(g1[1]) * u1[1]); w.w = cvt_pk_bf16(silu_f(g1[2]) * u1[2], silu_f(g1[3]) * u1[3]);
                *(u32x4*)rowp = w; }
    }
};
typedef float f32x2e __attribute__((ext_vector_type(2)));
__device__ __forceinline__ f32x2e swiglu8_2(f32x2e g, f32x2e u) {
    const f32x2e ng = g * -1.4426950408889634f; f32x2e e; e.x = __builtin_amdgcn_exp2f(ng.x); e.y = __builtin_amdgcn_exp2f(ng.y);
    const f32x2e d = e * 0.125f + 0.125f; f32x2e r; r.x = __builtin_amdgcn_rcpf(d.x); r.y = __builtin_amdgcn_rcpf(d.y);
    return (g * u) * r;
}
struct EpiSwiGLU8 {
    static constexpr bool PERM = true, AFTER_DRAIN = false, ROWSCALE = false;
    unsigned char* O; int ldc; int nct;
    __device__ __forceinline__ void operator()(const f32x4 (&acc)[2][2][4][2], const Unit& u, int wr, int wc, int fr, int fq) const {
        const int row0 = u.pm * BM + wr * 64 + fr; const int col0 = (u.pn % nct) * HALF + wc * 32 + 8 * fq;
#pragma unroll
        for (int ai = 0; ai < 2; ++ai)
#pragma unroll
            for (int m = 0; m < 4; ++m) { unsigned char* rowp = O + (size_t)(row0 + ai * HALF + m * 16) * ldc + col0;
                const f32x4 g0 = acc[ai][0][m][0], g1 = acc[ai][0][m][1], u0 = acc[ai][1][m][0], u1 = acc[ai][1][m][1];
                typedef unsigned u32x2 __attribute__((ext_vector_type(2))); u32x2 w;
                const f32x2e a0 = swiglu8_2((f32x2e){g0[0], g0[1]}, (f32x2e){u0[0], u0[1]}), a1 = swiglu8_2((f32x2e){g0[2], g0[3]}, (f32x2e){u0[2], u0[3]}), a2 = swiglu8_2((f32x2e){g1[0], g1[1]}, (f32x2e){u1[0], u1[1]}), a3 = swiglu8_2((f32x2e){g1[2], g1[3]}, (f32x2e){u1[2], u1[3]});
                w.x = pk_fp8x4(a0.x, a0.y, a1.x, a1.y);
                w.y = pk_fp8x4(a2.x, a2.y, a3.x, a3.y);
                *(u32x2*)rowp = w; }
    }
};
struct EpiSwiGLUScaled {
    static constexpr bool PERM = true, AFTER_DRAIN = false, ROWSCALE = true;
    bf16_t* O; int ldc; int nct; const float* rs; const PG8_LAS float* rsl;
    __device__ __forceinline__ void operator()(const f32x4 (&acc)[2][2][4][2], const Unit& u, int wr, int wc, int fr, int fq) const {
        const int row0 = u.pm * BM + wr * 64 + fr; const int col0 = (u.pn % nct) * HALF + wc * 32 + 8 * fq;
#pragma unroll
        for (int ai = 0; ai < 2; ++ai)
#pragma unroll
            for (int m = 0; m < 4; ++m) { const int row = row0 + ai * HALF + m * 16; const float s = rsl[wr * 64 + fr + ai * HALF + m * 16]; bf16_t* rowp = O + (size_t)row * ldc + col0;
                const f32x4 g0 = acc[ai][0][m][0] * s, g1 = acc[ai][0][m][1] * s, u0 = acc[ai][1][m][0] * s, u1 = acc[ai][1][m][1] * s;
                u32x4 w; w.x = cvt_pk_bf16(silu_f(g0[0]) * u0[0], silu_f(g0[1]) * u0[1]); w.y = cvt_pk_bf16(silu_f(g0[2]) * u0[2], silu_f(g0[3]) * u0[3]);
                w.z = cvt_pk_bf16(silu_f(g1[0]) * u1[0], silu_f(g1[1]) * u1[1]); w.w = cvt_pk_bf16(silu_f(g1[2]) * u1[2], silu_f(g1[3]) * u1[3]);
                *(u32x4*)rowp = w; }
    }
};
template <bool RF32> struct EpiResBf16 {
    static constexpr bool PERM = true, AFTER_DRAIN = false, ROWSCALE = false;
    bf16_t* O; const void* R; int ldc;
    __device__ __forceinline__ void operator()(const f32x4 (&acc)[2][2][4][2], const Unit& u, int wr, int wc, int fr, int fq) const {
        const int row0 = u.pm * BM + wr * 64 + fr; const int col0 = u.pn * BM + wc * 32 + 8 * fq;
        if constexpr (RF32) {
#pragma unroll
            for (int ai = 0; ai < 2; ++ai) { f32x4 r0[4][2], r1[4][2];
#pragma unroll
                for (int m = 0; m < 4; ++m)
#pragma unroll
                    for (int bj = 0; bj < 2; ++bj) { const size_t ro = (size_t)(row0 + ai * HALF + m * 16) * ldc + col0 + bj * HALF; r0[m][bj] = *(const f32x4*)((const float*)R + ro); r1[m][bj] = *(const f32x4*)((const float*)R + ro + 4); }
#pragma unroll
                for (int m = 0; m < 4; ++m)
#pragma unroll
                    for (int bj = 0; bj < 2; ++bj) { const size_t ro = (size_t)(row0 + ai * HALF + m * 16) * ldc + col0 + bj * HALF; const f32x4 v0 = acc[ai][bj][m][0] + r0[m][bj], v1 = acc[ai][bj][m][1] + r1[m][bj];
                        u32x4 w; w.x = cvt_pk_bf16(v0[0], v0[1]); w.y = cvt_pk_bf16(v0[2], v0[3]); w.z = cvt_pk_bf16(v1[0], v1[1]); w.w = cvt_pk_bf16(v1[2], v1[3]);
                        *(u32x4*)(O + ro) = w; } }
        } else {
            u32x4 rr[2][4][2];
#pragma unroll
            for (int ai = 0; ai < 2; ++ai)
#pragma unroll
                for (int m = 0; m < 4; ++m)
#pragma unroll
                    for (int bj = 0; bj < 2; ++bj) rr[ai][m][bj] = *(const u32x4*)((const bf16_t*)R + (size_t)(row0 + ai * HALF + m * 16) * ldc + col0 + bj * HALF);
#pragma unroll
            for (int ai = 0; ai < 2; ++ai)
#pragma unroll
                for (int m = 0; m < 4; ++m)
#pragma unroll
                    for (int bj = 0; bj < 2; ++bj) { const size_t ro = (size_t)(row0 + ai * HALF + m * 16) * ldc + col0 + bj * HALF; f32x4 v0 = acc[ai][bj][m][0], v1 = acc[ai][bj][m][1]; const u32x4 q = rr[ai][m][bj];
                        v0[0] += __builtin_bit_cast(float, q.x << 16); v0[1] += __builtin_bit_cast(float, q.x & 0xffff0000u); v0[2] += __builtin_bit_cast(float, q.y << 16); v0[3] += __builtin_bit_cast(float, q.y & 0xffff0000u);
                        v1[0] += __builtin_bit_cast(float, q.z << 16); v1[1] += __builtin_bit_cast(float, q.z & 0xffff0000u); v1[2] += __builtin_bit_cast(float, q.w << 16); v1[3] += __builtin_bit_cast(float, q.w & 0xffff0000u);
                        u32x4 w; w.x = cvt_pk_bf16(v0[0], v0[1]); w.y = cvt_pk_bf16(v0[2], v0[3]); w.z = cvt_pk_bf16(v1[0], v1[1]); w.w = cvt_pk_bf16(v1[2], v1[3]);
                        *(u32x4*)(O + ro) = w; }
        }
    }
};
struct MoeOrder {
    const PG8_LAS int* tp; int G, c;
    __device__ __forceinline__ bool next(int i, Unit& u) const {
        const int ntot = tp[16] * 4; const long L = (long)i * G + c; if (L >= ntot) return false;
        int wgid = (int)L; { const int q = ntot / NXCD, r = ntot % NXCD, xcd = wgid % NXCD, off = wgid / NXCD; wgid = (xcd < r ? xcd * (q + 1) : r * (q + 1) + (xcd - r) * q) + off; }
        const int rt = wgid >> 2, pnl = wgid & 3; int e = 0;
#pragma unroll
        for (int j = 1; j < 16; ++j) e += (rt >= tp[j]) ? 1 : 0;
        u.pm = rt; u.pn = __builtin_amdgcn_readfirstlane(e * 4 + pnl); return true;
    }
    __device__ __forceinline__ void a_ready(const Unit&) const {}
    __device__ __forceinline__ void done(const Unit&) const {}
};
template <class Epi, class Sched, bool ALIGN_EPI = false, bool SP2 = false, bool FP8 = false, int SCW = 127, int SCA = 127>
__device__ __forceinline__ void gemm_phase(PG8_LAS unsigned char* lds, const Gemm g, const Sched& S, const Epi& E) {
    const int tid = TIDX, wid = __builtin_amdgcn_readfirstlane(tid >> 6), lane = tid & 63, wr = wid >> 2, wc = wid & 3, fr = lane & 15, fq = lane >> 4;
    const int K = g.K; int nt = K / BK; if constexpr (FP8) asm volatile("" : "+s"(nt));
    unsigned voffA[2], voffB[2];
#pragma unroll
    for (int i = 0; i < 2; ++i) { int R, C; stage_rc(tid * 16 + i * 8192, R, C); const int Rb = Epi::PERM ? ((R & ~31) + perm32(R & 31)) : R;
        voffA[i] = (unsigned)(R * K + C) * 2u; voffB[i] = (unsigned)(Rb * K + C) * 2u; }
    const size_t kstep = (size_t)(BK * 2);
    const size_t hstep = (size_t)HALF * K * 2;
    const size_t tstep = 2 * hstep;
    const unsigned ldsw = (unsigned)wid * 1024u;
    int aoff = lds_byte(wr * 64 + fr, fq * 8), boff = lds_byte(wc * 32 + fr, fq * 8);
#define PG8_SA(b, h) (((b) * 2 + (h)) * HTB)
#define PG8_SB(b, h) ((4 + (b) * 2 + (h)) * HTB)
#define PG8_UNI(p) (FP8 ? (const char*)(((unsigned long long)(unsigned)__builtin_amdgcn_readfirstlane((int)((unsigned long long)(p) >> 32)) << 32) | (unsigned long long)(unsigned)__builtin_amdgcn_readfirstlane((int)(unsigned long long)(p))) : (const char*)(p))
#define PG8_STAGE(bufoff, gbase, voff) do { const char* _gb = PG8_UNI(gbase); _Pragma("unroll") for (int _i = 0; _i < 2; ++_i) \
        __builtin_amdgcn_global_load_lds((const unsigned*)(_gb + (voff)[_i]), (PG8_LAS unsigned*)(lds + (bufoff) + ldsw + _i * 8192), 16, 0, 0); } while (0)
#define PG8_LDA(dst, b, h) do { _Pragma("unroll") for (int m = 0; m < 4; ++m) { const bf16x8 _l0 = *(const PG8_LAS bf16x8*)(lds + PG8_SA(b, h) + aoff + m * 2048), _l1 = *(const PG8_LAS bf16x8*)(lds + PG8_SA(b, h) + aoff + m * 2048 + 1024); \
        if constexpr (FP8) dst##8[m] = cat8(_l0, _l1); else { dst[m][0] = _l0; dst[m][1] = _l1; } } } while (0)
#define PG8_LDB(dst, b, h) do { _Pragma("unroll") for (int n = 0; n < 2; ++n) { const bf16x8 _l0 = *(const PG8_LAS bf16x8*)(lds + PG8_SB(b, h) + boff + n * 2048), _l1 = *(const PG8_LAS bf16x8*)(lds + PG8_SB(b, h) + boff + n * 2048 + 1024); \
        if constexpr (FP8) dst##8[n] = cat8(_l0, _l1); else { dst[n][0] = _l0; dst[n][1] = _l1; } } } while (0)
#define PG8_MMA(ai, bj, At, Bt) do { __builtin_amdgcn_s_setprio(1); _Pragma("unroll") for (int m = 0; m < 4; ++m) _Pragma("unroll") for (int n = 0; n < 2; ++n) { \
        if constexpr (FP8) acc[ai][bj][m][n] = __builtin_amdgcn_mfma_scale_f32_16x16x128_f8f6f4(Bt##8[n], At##8[m], acc[ai][bj][m][n], 0, 0, 0, SCW, 0, SCA); \
        else { _Pragma("unroll") for (int k = 0; k < 2; ++k) acc[ai][bj][m][n] = __builtin_amdgcn_mfma_f32_16x16x32_bf16(Bt[n][k], At[m][k], acc[ai][bj][m][n], 0, 0, 0); } } \
        if constexpr (FP8) asm volatile("" : "+v"(acc[ai][bj][0][0]), "+v"(acc[ai][bj][0][1]), "+v"(acc[ai][bj][1][0]), "+v"(acc[ai][bj][1][1]), "+v"(acc[ai][bj][2][0]), "+v"(acc[ai][bj][2][1]), "+v"(acc[ai][bj][3][0]), "+v"(acc[ai][bj][3][1]));   \
        __builtin_amdgcn_s_setprio(0); } while (0)
#define PG8_WAIT_V(n) asm volatile("s_waitcnt vmcnt(" #n ")" ::: "memory")
#define PG8_WAIT_L(n) asm volatile("s_waitcnt lgkmcnt(" #n ")" ::: "memory")
#define PG8_BAR __builtin_amdgcn_s_barrier()
#define PG8_SCHED __builtin_amdgcn_sched_barrier(0)
    Unit cur, nxt; int ui = 0;
    if (!S.next(0, cur)) return;
    f32x4 acc[2][2][4][2];
#pragma unroll
    for (int a = 0; a < 2; ++a)
#pragma unroll
        for (int b = 0; b < 2; ++b)
#pragma unroll
            for (int m = 0; m < 4; ++m)
#pragma unroll
                for (int n = 0; n < 2; ++n) acc[a][b][m][n] = (f32x4){0.f, 0.f, 0.f, 0.f};
    bf16x8 At[4][2], B0[2][2], B1[2][2]; v8i_t At8[4], B08[2], B18[2];
    const char* cA = (const char*)g.A + (size_t)cur.pm * tstep; const char* cB = (const char*)g.Bt + (size_t)cur.pn * tstep;
    S.a_ready(cur);
    if constexpr (SP2) {
        PG8_STAGE(PG8_SB(0, 0), cB, voffB); PG8_STAGE(PG8_SB(0, 1), cB + hstep, voffB); PG8_STAGE(PG8_SA(0, 0), cA, voffA); PG8_STAGE(PG8_SA(0, 1), cA + hstep, voffA);
        if (wr == 1) PG8_BAR;
        PG8_WAIT_V(2); PG8_BAR;
        PG8_STAGE(PG8_SB(1, 0), cB + kstep, voffB); PG8_STAGE(PG8_SA(1, 0), cA + kstep, voffA); PG8_STAGE(PG8_SB(1, 1), cB + hstep + kstep, voffB);
        PG8_WAIT_V(6); PG8_BAR;
    } else {
        PG8_STAGE(PG8_SB(0, 0), cB, voffB); PG8_STAGE(PG8_SA(0, 0), cA, voffA); PG8_STAGE(PG8_SB(0, 1), cB + hstep, voffB); PG8_STAGE(PG8_SA(0, 1), cA + hstep, voffA);
        if (wr == 1) PG8_BAR;
        PG8_WAIT_V(4); PG8_BAR;
        PG8_STAGE(PG8_SB(1, 0), cB + kstep, voffB); PG8_STAGE(PG8_SA(1, 0), cA + kstep, voffA); PG8_STAGE(PG8_SB(1, 1), cB + hstep + kstep, voffB);
        PG8_WAIT_V(6); PG8_BAR;
    }
    for (;;) {
        const bool has_next = S.next(ui + 1, nxt);
        if constexpr (Epi::ROWSCALE) { if (wid >= 4) __builtin_amdgcn_global_load_lds((const unsigned*)(E.rs + cur.pm * BM + (wid - 4) * 64 + lane), (PG8_LAS unsigned*)(E.rsl + (wid - 4) * 64), 4, 0, 0); }
        const char* nA = has_next ? (const char*)g.A + (size_t)nxt.pm * tstep : cA; const char* nB = has_next ? (const char*)g.Bt + (size_t)nxt.pn * tstep : cB;
        for (int t = 0; t < nt; t += 2) {
            const bool last = (t == nt - 2);
            if constexpr (FP8) {
                int t_ = tid; asm volatile("" : "+v"(t_));
#pragma unroll
                for (int i = 0; i < 2; ++i) { int R, C; stage_rc(t_ * 16 + i * 8192, R, C); const int Rb = Epi::PERM ? ((R & ~31) + perm32(R & 31)) : R;
                    voffA[i] = (unsigned)(R * K + C) * 2u; voffB[i] = (unsigned)(Rb * K + C) * 2u; }
                const int fr_ = t_ & 15, fq_ = (t_ & 63) >> 4; aoff = lds_byte(wr * 64 + fr_, fq_ * 8); boff = lds_byte(wc * 32 + fr_, fq_ * 8); }
            const char* a1 = cA + (size_t)(t + 1) * kstep;
            const char* a2 = last ? nA : cA + (size_t)(t + 2) * kstep; const char* b2 = last ? nB : cB + (size_t)(t + 2) * kstep;
            const char* a3 = a2 + kstep; const char* b3 = b2 + kstep;
            if (last && has_next) S.a_ready(nxt);
            if constexpr (SP2) {
            PG8_LDB(B0, 0, 0); PG8_LDB(B1, 0, 1); PG8_SCHED; PG8_LDA(At, 0, 0); PG8_STAGE(PG8_SA(1, 1), a1 + hstep, voffA);
            PG8_WAIT_V(8); PG8_WAIT_L(0); PG8_BAR; PG8_MMA(0, 0, At, B0); PG8_MMA(0, 1, At, B1); PG8_BAR; PG8_SCHED;
            PG8_LDA(At, 0, 1); PG8_STAGE(PG8_SB(0, 0), b2, voffB); PG8_STAGE(PG8_SB(0, 1), b2 + hstep, voffB); PG8_STAGE(PG8_SA(0, 0), a2, voffA);
            PG8_WAIT_V(8); PG8_WAIT_L(0); PG8_BAR; PG8_MMA(1, 0, At, B0); PG8_MMA(1, 1, At, B1); PG8_BAR; PG8_SCHED;
            PG8_LDB(B0, 1, 0); PG8_LDB(B1, 1, 1); PG8_SCHED; PG8_LDA(At, 1, 0); PG8_STAGE(PG8_SA(0, 1), a2 + hstep, voffA);
            PG8_WAIT_V(8); PG8_WAIT_L(0); PG8_BAR; PG8_MMA(0, 0, At, B0); PG8_MMA(0, 1, At, B1); PG8_BAR; PG8_SCHED;
            PG8_LDA(At, 1, 1); PG8_STAGE(PG8_SB(1, 0), b3, voffB); PG8_STAGE(PG8_SB(1, 1), b3 + hstep, voffB); PG8_STAGE(PG8_SA(1, 0), a3, voffA);
            PG8_WAIT_V(8); PG8_WAIT_L(0); PG8_BAR; PG8_MMA(1, 0, At, B0); PG8_MMA(1, 1, At, B1); PG8_BAR; PG8_SCHED;
            } else {
            PG8_LDB(B0, 0, 0); PG8_SCHED; PG8_LDA(At, 0, 0); PG8_STAGE(PG8_SA(1, 1), a1 + hstep, voffA);
            PG8_WAIT_L(8); PG8_BAR; PG8_WAIT_L(0); PG8_MMA(0, 0, At, B0); PG8_BAR; PG8_SCHED;
            PG8_LDB(B1, 0, 1); PG8_STAGE(PG8_SB(0, 0), b2, voffB);
            PG8_BAR; PG8_WAIT_L(0); PG8_MMA(0, 1, At, B1); PG8_BAR;
            PG8_LDA(At, 0, 1); PG8_STAGE(PG8_SA(0, 0), a2, voffA);
            PG8_BAR; PG8_WAIT_L(0); PG8_MMA(1, 0, At, B0); PG8_BAR; PG8_SCHED;
            PG8_STAGE(PG8_SB(0, 1), b2 + hstep, voffB);
            PG8_WAIT_V(6); PG8_BAR; PG8_MMA(1, 1, At, B1); PG8_BAR;
            PG8_LDB(B0, 1, 0); PG8_SCHED; PG8_LDA(At, 1, 0); PG8_STAGE(PG8_SA(0, 1), a2 + hstep, voffA);
            PG8_WAIT_L(8); PG8_BAR; PG8_WAIT_L(0); PG8_MMA(0, 0, At, B0); PG8_BAR; PG8_SCHED;
            PG8_LDB(B1, 1, 1); PG8_STAGE(PG8_SB(1, 0), b3, voffB);
            PG8_BAR; PG8_WAIT_L(0); PG8_MMA(0, 1, At, B1); PG8_BAR;
            PG8_LDA(At, 1, 1); PG8_STAGE(PG8_SA(1, 0), a3, voffA);
            PG8_BAR; PG8_WAIT_L(0); PG8_MMA(1, 0, At, B0); PG8_BAR; PG8_SCHED;
            PG8_STAGE(PG8_SB(1, 1), b3 + hstep, voffB);
            PG8_WAIT_V(6); PG8_BAR; PG8_MMA(1, 1, At, B1); PG8_BAR;
            }
        }
        if constexpr (ALIGN_EPI) { if (wr == 0) PG8_BAR; }
        if constexpr (!Epi::AFTER_DRAIN) { E(acc, cur, wr, wc, fr, fq); S.done(cur); }
        if (!has_next) break;
#pragma unroll
        for (int a = 0; a < 2; ++a)
#pragma unroll
            for (int b = 0; b < 2; ++b)
#pragma unroll
                for (int m = 0; m < 4; ++m)
#pragma unroll
                    for (int n = 0; n < 2; ++n) acc[a][b][m][n] = (f32x4){0.f, 0.f, 0.f, 0.f};
        cur = nxt; cA = nA; cB = nB; ++ui;
        if constexpr (ALIGN_EPI) { if (wr == 1) PG8_BAR; }
    }
    PG8_WAIT_V(0);
    if constexpr (!ALIGN_EPI) { if (wr == 0) PG8_BAR; }
    PG8_BAR;
    if constexpr (Epi::AFTER_DRAIN) { E.fused(acc, cur, wr, wc, fr, fq, lds, wid, lane); S.done(cur); }
#undef PG8_SA
#undef PG8_SB
#undef PG8_STAGE
#undef PG8_UNI
#undef PG8_LDA
#undef PG8_LDB
#undef PG8_MMA
#undef PG8_WAIT_V
#undef PG8_WAIT_L
#undef PG8_BAR
#undef PG8_SCHED
}

template <class Epi, class Sched, bool FP8 = false, int SCW = 127, int SCA = 127>
__device__ __forceinline__ void gemm_phase_gather(PG8_LAS unsigned char* lds, const Gemm g, const unsigned* rowoff, PG8_LAS unsigned* tab, const Sched& S, const Epi& E) {
    constexpr bool ALIGN_EPI = true, SP2 = true;
    const int tid = TIDX, wid = __builtin_amdgcn_readfirstlane(tid >> 6), lane = tid & 63, wr = wid >> 2, wc = wid & 3, fr = lane & 15, fq = lane >> 4;
    const int K = g.K; int nt = K / BK; if constexpr (FP8) asm volatile("" : "+s"(nt));
    unsigned voffA[2], voffB[2], colA[2]; int rowA[2];
#pragma unroll
    for (int i = 0; i < 2; ++i) { int R, C; stage_rc(tid * 16 + i * 8192, R, C); const int Rb = Epi::PERM ? ((R & ~31) + perm32(R & 31)) : R;
        voffA[i] = (unsigned)(R * K + C) * 2u; voffB[i] = (unsigned)(Rb * K + C) * 2u; rowA[i] = R; colA[i] = (unsigned)C * 2u; }
    const size_t kstep = (size_t)(BK * 2);
    const size_t hstep = (size_t)HALF * K * 2;
    const size_t tstep = 2 * hstep;
    const unsigned ldsw = (unsigned)wid * 1024u;
    int aoff = lds_byte(wr * 64 + fr, fq * 8), boff = lds_byte(wc * 32 + fr, fq * 8);
#define PG8_SA(b, h) (((b) * 2 + (h)) * HTB)
#define PG8_SB(b, h) ((4 + (b) * 2 + (h)) * HTB)
#define PG8_UNI(p) (FP8 ? (const char*)(((unsigned long long)(unsigned)__builtin_amdgcn_readfirstlane((int)((unsigned long long)(p) >> 32)) << 32) | (unsigned long long)(unsigned)__builtin_amdgcn_readfirstlane((int)(unsigned long long)(p))) : (const char*)(p))
#define PG8_STAGE(bufoff, gbase, voff) do { const char* _gb = PG8_UNI(gbase); _Pragma("unroll") for (int _i = 0; _i < 2; ++_i) \
        __builtin_amdgcn_global_load_lds((const unsigned*)(_gb + (voff)[_i]), (PG8_LAS unsigned*)(lds + (bufoff) + ldsw + _i * 8192), 16, 0, 0); } while (0)
#define PG8_STAGE_A(bufoff, kbase, OFF, hf) do { const char* _gb = PG8_UNI(kbase); _Pragma("unroll") for (int _i = 0; _i < 2; ++_i) \
        __builtin_amdgcn_global_load_lds((const unsigned*)(_gb + (OFF)[hf][_i]), (PG8_LAS unsigned*)(lds + (bufoff) + ldsw + _i * 8192), 16, 0, 0); } while (0)
#define PG8_LDA(dst, b, h) do { _Pragma("unroll") for (int m = 0; m < 4; ++m) { const bf16x8 _l0 = *(const PG8_LAS bf16x8*)(lds + PG8_SA(b, h) + aoff + m * 2048), _l1 = *(const PG8_LAS bf16x8*)(lds + PG8_SA(b, h) + aoff + m * 2048 + 1024); \
        if constexpr (FP8) dst##8[m] = cat8(_l0, _l1); else { dst[m][0] = _l0; dst[m][1] = _l1; } } } while (0)
#define PG8_LDB(dst, b, h) do { _Pragma("unroll") for (int n = 0; n < 2; ++n) { const bf16x8 _l0 = *(const PG8_LAS bf16x8*)(lds + PG8_SB(b, h) + boff + n * 2048), _l1 = *(const PG8_LAS bf16x8*)(lds + PG8_SB(b, h) + boff + n * 2048 + 1024); \
        if constexpr (FP8) dst##8[n] = cat8(_l0, _l1); else { dst[n][0] = _l0; dst[n][1] = _l1; } } } while (0)
#define PG8_MMA(ai, bj, At, Bt) do { __builtin_amdgcn_s_setprio(1); _Pragma("unroll") for (int m = 0; m < 4; ++m) _Pragma("unroll") for (int n = 0; n < 2; ++n) { \
        if constexpr (FP8) acc[ai][bj][m][n] = __builtin_amdgcn_mfma_scale_f32_16x16x128_f8f6f4(Bt##8[n], At##8[m], acc[ai][bj][m][n], 0, 0, 0, SCW, 0, SCA); \
        else { _Pragma("unroll") for (int k = 0; k < 2; ++k) acc[ai][bj][m][n] = __builtin_amdgcn_mfma_f32_16x16x32_bf16(Bt[n][k], At[m][k], acc[ai][bj][m][n], 0, 0, 0); } } \
        if constexpr (FP8) asm volatile("" : "+v"(acc[ai][bj][0][0]), "+v"(acc[ai][bj][0][1]), "+v"(acc[ai][bj][1][0]), "+v"(acc[ai][bj][1][1]), "+v"(acc[ai][bj][2][0]), "+v"(acc[ai][bj][2][1]), "+v"(acc[ai][bj][3][0]), "+v"(acc[ai][bj][3][1]));   \
        __builtin_amdgcn_s_setprio(0); } while (0)
#define PG8_WAIT_V(n) asm volatile("s_waitcnt vmcnt(" #n ")" ::: "memory")
#define PG8_WAIT_L(n) asm volatile("s_waitcnt lgkmcnt(" #n ")" ::: "memory")
#define PG8_BAR __builtin_amdgcn_s_barrier()
#define PG8_SCHED __builtin_amdgcn_sched_barrier(0)
    Unit cur, nxt; int ui = 0;
    if (!S.next(0, cur)) return;
    f32x4 acc[2][2][4][2];
#pragma unroll
    for (int a = 0; a < 2; ++a)
#pragma unroll
        for (int b = 0; b < 2; ++b)
#pragma unroll
            for (int m = 0; m < 4; ++m)
#pragma unroll
                for (int n = 0; n < 2; ++n) acc[a][b][m][n] = (f32x4){0.f, 0.f, 0.f, 0.f};
    bf16x8 At[4][2], B0[2][2], B1[2][2]; v8i_t At8[4], B08[2], B18[2];
    const char* const kA = (const char*)g.A; const char* cB = (const char*)g.Bt + (size_t)cur.pn * tstep;
    unsigned curOff[2][2];
#pragma unroll
    for (int hf = 0; hf < 2; ++hf)
#pragma unroll
        for (int i = 0; i < 2; ++i) { curOff[hf][i] = rowoff[cur.pm * BM + hf * HALF + rowA[i]] + colA[i]; }
    S.a_ready(cur);
    if constexpr (SP2) {
        PG8_STAGE(PG8_SB(0, 0), cB, voffB); PG8_STAGE(PG8_SB(0, 1), cB + hstep, voffB); PG8_STAGE_A(PG8_SA(0, 0), kA, curOff, 0); PG8_STAGE_A(PG8_SA(0, 1), kA, curOff, 1);
        if (wr == 1) PG8_BAR;
        PG8_WAIT_V(2); PG8_BAR;
        PG8_STAGE(PG8_SB(1, 0), cB + kstep, voffB); PG8_STAGE_A(PG8_SA(1, 0), kA + kstep, curOff, 0); PG8_STAGE(PG8_SB(1, 1), cB + hstep + kstep, voffB);
        PG8_WAIT_V(6); PG8_BAR;
    }
    for (;;) {
        const bool has_next = S.next(ui + 1, nxt);
        if constexpr (Epi::ROWSCALE) { if (wid >= 4) __builtin_amdgcn_global_load_lds((const unsigned*)(E.rs + cur.pm * BM + (wid - 4) * 64 + lane), (PG8_LAS unsigned*)(E.rsl + (wid - 4) * 64), 4, 0, 0); }
        const char* nB = has_next ? (const char*)g.Bt + (size_t)nxt.pn * tstep : cB;
        int dma_pending = has_next ? 1 : 0; asm volatile("" : "+v"(dma_pending));
        for (int t = 0; t < nt; t += 2) {
            const bool last = (t == nt - 2);
            if constexpr (FP8) {
                int t_ = tid; asm volatile("" : "+v"(t_));
#pragma unroll
                for (int i = 0; i < 2; ++i) { int R, C; stage_rc(t_ * 16 + i * 8192, R, C); const int Rb = Epi::PERM ? ((R & ~31) + perm32(R & 31)) : R;
                    voffA[i] = (unsigned)(R * K + C) * 2u; voffB[i] = (unsigned)(Rb * K + C) * 2u; rowA[i] = R; colA[i] = (unsigned)C * 2u; }
                const int fr_ = t_ & 15, fq_ = (t_ & 63) >> 4; aoff = lds_byte(wr * 64 + fr_, fq_ * 8); boff = lds_byte(wc * 32 + fr_, fq_ * 8); }
            const char* a1 = kA + (size_t)(t + 1) * kstep;
            const char* a2 = last ? kA : kA + (size_t)(t + 2) * kstep; const char* b2 = last ? nB : cB + (size_t)(t + 2) * kstep;
            unsigned o2[2][2];
#pragma unroll
            for (int hf = 0; hf < 2; ++hf)
#pragma unroll
                for (int i = 0; i < 2; ++i) o2[hf][i] = (last && has_next) ? tab[hf * HALF + rowA[i]] + colA[i] : curOff[hf][i];
            const char* a3 = a2 + kstep; const char* b3 = b2 + kstep;
            if (last && has_next) S.a_ready(nxt);
            if constexpr (SP2) {
            PG8_LDB(B0, 0, 0); PG8_LDB(B1, 0, 1); PG8_SCHED; PG8_LDA(At, 0, 0); PG8_STAGE_A(PG8_SA(1, 1), a1, curOff, 1);
            PG8_WAIT_V(8); PG8_WAIT_L(0); PG8_BAR;
            if (dma_pending && wid < 4) __builtin_amdgcn_global_load_lds(rowoff + nxt.pm * BM + wid * 64 + lane, (PG8_LAS unsigned*)(tab + wid * 64), 4, 0, 0);
            dma_pending = 0; asm volatile("" : "+v"(dma_pending));
            PG8_MMA(0, 0, At, B0); PG8_MMA(0, 1, At, B1); PG8_BAR; PG8_SCHED;
            PG8_LDA(At, 0, 1); PG8_STAGE(PG8_SB(0, 0), b2, voffB); PG8_STAGE(PG8_SB(0, 1), b2 + hstep, voffB); PG8_STAGE_A(PG8_SA(0, 0), a2, o2, 0);
            PG8_WAIT_V(8); PG8_WAIT_L(0); PG8_BAR; PG8_MMA(1, 0, At, B0); PG8_MMA(1, 1, At, B1); PG8_BAR; PG8_SCHED;
            PG8_LDB(B0, 1, 0); PG8_LDB(B1, 1, 1); PG8_SCHED; PG8_LDA(At, 1, 0); PG8_STAGE_A(PG8_SA(0, 1), a2, o2, 1);
            PG8_WAIT_V(8); PG8_WAIT_L(0); PG8_BAR; PG8_MMA(0, 0, At, B0); PG8_MMA(0, 1, At, B1); PG8_BAR; PG8_SCHED;
            PG8_LDA(At, 1, 1); PG8_STAGE(PG8_SB(1, 0), b3, voffB); PG8_STAGE(PG8_SB(1, 1), b3 + hstep, voffB); PG8_STAGE_A(PG8_SA(1, 0), a3, o2, 0);
            PG8_WAIT_V(8); PG8_WAIT_L(0); PG8_BAR; PG8_MMA(1, 0, At, B0); PG8_MMA(1, 1, At, B1); PG8_BAR; PG8_SCHED;
            }
        }
        if constexpr (ALIGN_EPI) { if (wr == 0) PG8_BAR; }
        if constexpr (!Epi::AFTER_DRAIN) { E(acc, cur, wr, wc, fr, fq); S.done(cur); }
        if (!has_next) break;
#pragma unroll
        for (int a = 0; a < 2; ++a)
#pragma unroll
            for (int b = 0; b < 2; ++b)
#pragma unroll
                for (int m = 0; m < 4; ++m)
#pragma unroll
                    for (int n = 0; n < 2; ++n) acc[a][b][m][n] = (f32x4){0.f, 0.f, 0.f, 0.f};
        cur = nxt; cB = nB; ++ui;
#pragma unroll
        for (int hf = 0; hf < 2; ++hf)
#pragma unroll
            for (int i = 0; i < 2; ++i) curOff[hf][i] = tab[hf * HALF + rowA[i]] + colA[i];
        if constexpr (ALIGN_EPI) { if (wr == 1) PG8_BAR; }
    }
    PG8_WAIT_V(0);
    if constexpr (!ALIGN_EPI) { if (wr == 0) PG8_BAR; }
    PG8_BAR;
    if constexpr (Epi::AFTER_DRAIN) { E.fused(acc, cur, wr, wc, fr, fq, lds, wid, lane); S.done(cur); }
#undef PG8_SA
#undef PG8_SB
#undef PG8_STAGE
#undef PG8_UNI
#undef PG8_STAGE_A
#undef PG8_LDA
#undef PG8_LDB
#undef PG8_MMA
#undef PG8_WAIT_V
#undef PG8_WAIT_L
#undef PG8_BAR
#undef PG8_SCHED
}

}
#define GAS __attribute__((address_space(1)))
#define LAS __attribute__((address_space(3)))
typedef unsigned short bf16;
typedef unsigned v4u __attribute__((ext_vector_type(4)));
typedef unsigned v2u __attribute__((ext_vector_type(2)));
typedef float f32x4 __attribute__((ext_vector_type(4)));
constexpr int BATCH = 8, SEQ = 4096, D = 1024, T = BATCH * SEQ;
constexpr int GH = 4, DK = 128, DV = 256, QKD = 512, GR = 16, AIN = 3088, CH = 64, NCH = SEQ / CH;
constexpr int SBH = 16, SBD = 64;
constexpr int NE = 16, DE = 512, NPROJ = 3072;
constexpr float EPS = 1e-6f;
constexpr int MAXTILES = T * 2 / 256 + NE, XROWS = MAXTILES * 256;
constexpr size_t MiB = 1u << 20;
constexpr size_t WS_CTL = 0, CTL_ZERO_BYTES = 64 * 1024;
constexpr size_t WS_WIN = 2 * MiB, WS_WAO = 8 * MiB, WS_WQKV = 10 * MiB, WS_WBO = 16 * MiB, WS_W1 = 18 * MiB, WS_W2 = 82 * MiB;
constexpr size_t WS_PROJ = 114 * MiB;
constexpr size_t WS_U = 306 * MiB;
constexpr size_t WS_HDN = 114 * MiB;
constexpr size_t WS_H8 = 434 * MiB;
constexpr size_t WS_Y = 182 * MiB;
constexpr size_t WS_ST = 370 * MiB;
constexpr size_t WS_H = 370 * MiB;
constexpr size_t WS_GKLR = 506 * MiB;
constexpr size_t WS_TOK = 508 * MiB;
constexpr size_t WS_RS1 = 509 * MiB;
constexpr size_t WS_RS2 = 509 * MiB + 288 * 1024;
constexpr size_t WS_ROWOFF = 509 * MiB + 576 * 1024;
constexpr size_t WS_ROWID = 511 * MiB + 512 * 1024;
constexpr size_t WS_RSTD = 511 * MiB + 128 * 1024;
constexpr size_t WS_END = 512 * MiB;
constexpr int CW_CNT = 64;
constexpr int CW_CUR = 256;
constexpr int CW_BAR = 4096;

__device__ __forceinline__ unsigned f2bf(float f) { unsigned u = __builtin_bit_cast(unsigned, f); return (u + 0x7fffu + ((u >> 16) & 1u)) >> 16; }
__device__ __forceinline__ unsigned pk2(float lo, float hi) { return f2bf(lo) | (f2bf(hi) << 16); }
__device__ __forceinline__ float bf2f(unsigned short b) { return __builtin_bit_cast(float, (unsigned)b << 16); }
__device__ __forceinline__ float bflo(unsigned w) { return __builtin_bit_cast(float, w << 16); }
__device__ __forceinline__ float bfhi(unsigned w) { return __builtin_bit_cast(float, w & 0xffff0000u); }
__device__ __forceinline__ float wave_sum(float v) {
#pragma unroll
    for (int o = 1; o < 64; o <<= 1) v += __shfl_xor(v, o);
    return v;
}
__device__ __forceinline__ float logsigmoidf_(float x) { return fminf(x, 0.f) - log1pf(__expf(-fabsf(x))); }
__device__ __forceinline__ float softplusf_(float x) { return fmaxf(x, 0.f) + log1pf(__expf(-fabsf(x))); }

struct TItem { const float* src; const float* gain; bf16* dst; int ldw, K; float scale; int fp8; };
__device__ __forceinline__ void ti_load(const TItem& t, int lane, float (&wv)[32], f32x4& g0, f32x4& g1) {
    g0 = (f32x4){1.f, 1.f, 1.f, 1.f}; g1 = g0;
    if (t.gain) { g0 = *(const f32x4*)(t.gain + 8 * (lane & 7)); g1 = *(const f32x4*)(t.gain + 8 * (lane & 7) + 4); }
    const float* wp = t.src + (size_t)(lane >> 5) * t.ldw + (lane & 31);
#pragma unroll
    for (int i = 0; i < 32; ++i) wv[i] = wp[(size_t)(2 * i) * t.ldw];
}
__device__ __forceinline__ void ti_process(const TItem& t, int lane, const float (&wv)[32], f32x4 g0, f32x4 g1, LAS float* scr) {
#pragma unroll
    for (int i = 0; i < 32; ++i) scr[(2 * i + (lane >> 5)) * 33 + (lane & 31)] = wv[i];
    __builtin_amdgcn_wave_barrier(); asm volatile("s_waitcnt lgkmcnt(0)" ::: "memory");
    const int c = lane & 7; g0 = g0 * t.scale; g1 = g1 * t.scale;
    if (t.fp8) {
#pragma unroll
        for (int j = 0; j < 4; ++j) { const int n = (lane >> 3) + 8 * j; const LAS float* s = scr + (8 * c) * 33 + n;
            v2u o; o.x = pg8::pk_fp8x4(s[0 * 33] * g0.x, s[1 * 33] * g0.y, s[2 * 33] * g0.z, s[3 * 33] * g0.w); o.y = pg8::pk_fp8x4(s[4 * 33] * g1.x, s[5 * 33] * g1.y, s[6 * 33] * g1.z, s[7 * 33] * g1.w);
            *(v2u*)((unsigned char*)t.dst + (size_t)n * t.K + 8 * c) = o; }
    } else {
#pragma unroll
        for (int j = 0; j < 4; ++j) { const int n = (lane >> 3) + 8 * j; const LAS float* s = scr + (8 * c) * 33 + n;
            v4u o; o.x = pk2(s[0 * 33] * g0.x, s[1 * 33] * g0.y); o.y = pk2(s[2 * 33] * g0.z, s[3 * 33] * g0.w); o.z = pk2(s[4 * 33] * g1.x, s[5 * 33] * g1.y); o.w = pk2(s[6 * 33] * g1.z, s[7 * 33] * g1.w);
            *(v4u*)(t.dst + (size_t)n * t.K + 8 * c) = o; }
    }
    __builtin_amdgcn_wave_barrier(); asm volatile("s_waitcnt lgkmcnt(0)" ::: "memory");
}
struct In {
    const float *x, *a_norm, *a_w_in, *a_w_gk2, *a_b_gk2, *a_o_norm, *a_w_out, *kv_norm, *w_kv, *b_norm, *b_w_q, *b_w_out, *m_norm, *m_w_group, *m_b_group, *m_w_expert, *m_b_expert, *m_w_gate, *m_w_up, *m_w_down, *final_norm;
};
constexpr float W8_SCALE = 8.f, A8_SCALE = 8.f;
constexpr int IT_WIN = 16 * 96, IT_AO = 16 * 32, IT_Q = 16 * 32, IT_KV = 16 * 64, IT_BO = 16 * 32, IT_W1 = 32 * 16 * 32, IT_W2 = 32 * 8 * 32;
constexpr int IT_TOTAL = IT_WIN + IT_AO + IT_Q + IT_KV + IT_BO + IT_W1 + IT_W2, IT_L1 = IT_TOTAL - (IT_W1 + IT_W2) / 2;
__device__ __forceinline__ TItem make_item(const In& in, unsigned char* ws, int it) {
    TItem t; t.fp8 = 0; int r = it;
    if (r < IT_WIN) { const int kb = r / 96, nb = r % 96, n0 = nb * 32, k0 = kb * 64; t.src = in.a_w_in + (size_t)k0 * AIN + n0 + (n0 >= 2048 ? 16 : 0); t.ldw = AIN; t.gain = in.a_norm + k0; t.scale = n0 < QKD ? 0.08838834764831845f : 1.f; t.dst = (bf16*)(ws + WS_WIN) + (size_t)n0 * D + k0; t.K = D; return t; } r -= IT_WIN;
    if (r < IT_AO) { const int kb = r / 32, nb = r % 32, k0 = kb * 64; t.src = in.a_w_out + (size_t)k0 * D + nb * 32; t.ldw = D; t.gain = in.a_o_norm + (k0 & (DV - 1)); t.scale = 1.f; t.dst = (bf16*)(ws + WS_WAO) + (size_t)(nb * 32) * D + k0; t.K = D; return t; } r -= IT_AO;
    if (r < IT_Q) { const int kb = r / 32, nb = r % 32, k0 = kb * 64; t.src = in.b_w_q + (size_t)k0 * D + nb * 32; t.ldw = D; t.gain = in.b_norm + k0; t.scale = 0.125f * 1.4426950408889634f; t.dst = (bf16*)(ws + WS_WQKV) + (size_t)(nb * 32) * D + k0; t.K = D; return t; } r -= IT_Q;
    if (r < IT_KV) { const int kb = r / 64, nb = r % 64, k0 = kb * 64; t.src = in.w_kv + (size_t)k0 * (2 * D) + nb * 32; t.ldw = 2 * D; t.gain = in.kv_norm + k0; t.scale = 1.f; t.dst = (bf16*)(ws + WS_WQKV) + (size_t)(D + nb * 32) * D + k0; t.K = D; return t; } r -= IT_KV;
    if (r < IT_BO) { const int kb = r / 32, nb = r % 32, k0 = kb * 64; t.src = in.b_w_out + (size_t)k0 * D + nb * 32; t.ldw = D; t.gain = nullptr; t.scale = 1.f; t.dst = (bf16*)(ws + WS_WBO) + (size_t)(nb * 32) * D + k0; t.K = D; return t; } r -= IT_BO;
    { const int l = r >= (IT_W1 + IT_W2) / 2 ? 1 : 0; r -= l * ((IT_W1 + IT_W2) / 2);
      if (r < IT_W1 / 2) { const int le = l * 16 + r / 512, q = r % 512, kb = q / 32, nb = q % 32, vr0 = nb * 32, pn = vr0 >> 8, bj = (vr0 >> 7) & 1, r0 = vr0 & 127, k0 = kb * 64;
        t.src = (bj ? in.m_w_up : in.m_w_gate) + (size_t)le * D * DE + (size_t)k0 * DE + 128 * pn + r0; t.ldw = DE; t.gain = in.m_norm + l * D + k0; t.scale = W8_SCALE; t.fp8 = 1; t.dst = (bf16*)(ws + WS_W1 + (size_t)le * 1024 * D + (size_t)vr0 * D + k0); t.K = D; return t; }
      r -= IT_W1 / 2;
      { const int le = l * 16 + r / 256, q = r % 256, kb = q / 32, nb = q % 32, k0 = kb * 64;
        t.src = in.m_w_down + (size_t)le * DE * D + (size_t)k0 * D + nb * 32; t.ldw = D; t.gain = nullptr; t.scale = W8_SCALE; t.fp8 = 1; t.dst = (bf16*)(ws + WS_W2 + (size_t)le * 1024 * DE + (size_t)(nb * 32) * DE + k0); t.K = DE; return t; } }
}
__device__ __forceinline__ void prologue_items(const In& in, unsigned char* ws, LAS float* scr, int gw, int ngw, int lane, int it0, int it1) {
    if (it0 + gw >= it1) return;
    TItem cur = make_item(in, ws, it0 + gw); float wa[32]; f32x4 ga0, ga1; ti_load(cur, lane, wa, ga0, ga1);
    for (int it = it0 + gw; it < it1; it += ngw) {
        const int nx = it + ngw; const bool has = nx < it1; const TItem nxt = make_item(in, ws, has ? nx : it); float wb[32]; f32x4 gb0, gb1; ti_load(nxt, lane, wb, gb0, gb1);
        ti_process(cur, lane, wa, ga0, ga1, scr);
        cur = nxt; ga0 = gb0; ga1 = gb1;
#pragma unroll
        for (int i = 0; i < 32; ++i) wa[i] = wb[i];
    }
}
__device__ __forceinline__ void load_row(const float* row, int lane, f32x4 (&v)[4]) {
#pragma unroll
    for (int j = 0; j < 4; ++j) v[j] = *(const f32x4*)(row + 256 * j + 4 * lane);
}
__device__ __forceinline__ void load_row_bf16(const bf16* row, int lane, f32x4 (&v)[4]) {
#pragma unroll
    for (int j = 0; j < 4; ++j) { const uint2 o = *(const uint2*)(row + 256 * j + 4 * lane); v[j].x = bflo(o.x); v[j].y = bfhi(o.x); v[j].z = bflo(o.y); v[j].w = bfhi(o.y); }
}
__device__ __forceinline__ float row_ssq(const f32x4 (&v)[4]) { float s = 0.f;
#pragma unroll
    for (int j = 0; j < 4; ++j) s += (v[j].x * v[j].x + v[j].y * v[j].y) + (v[j].z * v[j].z + v[j].w * v[j].w);
    return wave_sum(s); }
__device__ __forceinline__ void store_row_bf16(bf16* row, int lane, const f32x4 (&v)[4], float s) {
#pragma unroll
    for (int j = 0; j < 4; ++j) { uint2 o; o.x = pk2(v[j].x * s, v[j].y * s); o.y = pk2(v[j].z * s, v[j].w * s); *(uint2*)(row + 256 * j + 4 * lane) = o; }
}
__device__ __forceinline__ void add_row_bf16(const bf16* row, int lane, f32x4 (&v)[4]) {
#pragma unroll
    for (int j = 0; j < 4; ++j) { const uint2 o = *(const uint2*)(row + 256 * j + 4 * lane); v[j].x += bflo(o.x); v[j].y += bfhi(o.x); v[j].z += bflo(o.y); v[j].w += bfhi(o.y); }
}
template <int C> __device__ __forceinline__ float row_dots2(const f32x4 (&va)[4], const f32x4 (&vb)[4], const LAS float* Wl, int lane) {
    float res = 0.f; const bool up5 = (lane & 32) != 0, up4 = (lane & 16) != 0;
    typedef float f32x2v __attribute__((ext_vector_type(2)));
#pragma unroll 1
    for (int cp = 0; cp < C / 2; ++cp) { f32x2v pa0 = {0.f, 0.f}, pa1 = pa0, pb0 = pa0, pb1 = pa0; const LAS float* wp = Wl + cp * 2048 + 4 * lane;
#pragma unroll
        for (int j = 0; j < 4; ++j) { const f32x4 w0 = *(const LAS f32x4*)(wp + 256 * j), w1 = *(const LAS f32x4*)(wp + 1024 + 256 * j);
            const f32x2v w0l = {w0.x, w0.y}, w0h = {w0.z, w0.w}, w1l = {w1.x, w1.y}, w1h = {w1.z, w1.w}, al = {va[j].x, va[j].y}, ah = {va[j].z, va[j].w}, bl = {vb[j].x, vb[j].y}, bh = {vb[j].z, vb[j].w};
            pa0 += al * w0l; pa0 += ah * w0h; pa1 += al * w1l; pa1 += ah * w1h; pb0 += bl * w0l; pb0 += bh * w0h; pb1 += bl * w1l; pb1 += bh * w1h; }
        const float a0 = pa0.x + pa0.y, a1 = pa1.x + pa1.y, b0 = pb0.x + pb0.y, b1 = pb1.x + pb1.y;
        const float k0 = up5 ? b0 : a0, k1 = up5 ? b1 : a1, s0 = up5 ? a0 : b0, s1 = up5 ? a1 : b1;
        const float w0 = k0 + __shfl_xor(s0, 32), w1 = k1 + __shfl_xor(s1, 32);
        float u = (up4 ? w1 : w0) + __shfl_xor(up4 ? w0 : w1, 16);
        u += __shfl_xor(u, 8); u += __shfl_xor(u, 4); u += __shfl_xor(u, 2); u += __shfl_xor(u, 1);
        res = ((lane & 15) == cp) ? u : res; }
    return res;
}
__device__ __forceinline__ void row_ssq2(const f32x4 (&va)[4], const f32x4 (&vb)[4], int lane, float& sa, float& sb) {
    float a = 0.f, b = 0.f;
#pragma unroll
    for (int j = 0; j < 4; ++j) { a += (va[j].x * va[j].x + va[j].y * va[j].y) + (va[j].z * va[j].z + va[j].w * va[j].w); b += (vb[j].x * vb[j].x + vb[j].y * vb[j].y) + (vb[j].z * vb[j].z + vb[j].w * vb[j].w); }
    const bool up5 = (lane & 32) != 0;
    float u = (up5 ? b : a) + __shfl_xor(up5 ? a : b, 32);
    u += __shfl_xor(u, 16); u += __shfl_xor(u, 8); u += __shfl_xor(u, 4); u += __shfl_xor(u, 2); u += __shfl_xor(u, 1);
    sa = __shfl(u, 0); sb = __shfl(u, 32);
}
__device__ __forceinline__ void ph_norm_in(const In& in, unsigned char* ws, LAS float* Wl) {
    { f32x4 w4[2][4]; float gk[2];
#pragma unroll
      for (int q = 0; q < 2; ++q) { const int k = TIDX + 512 * q; gk[q] = in.a_norm[k];
#pragma unroll
          for (int j = 0; j < 4; ++j) w4[q][j] = *(const f32x4*)(in.a_w_in + (size_t)k * AIN + 2048 + 4 * j); }
#pragma unroll
      for (int q = 0; q < 2; ++q) { const int k = TIDX + 512 * q;
#pragma unroll
          for (int c = 0; c < 16; ++c) Wl[c * 1024 + k] = gk[q] * w4[q][c >> 2][c & 3]; } }
    __syncthreads();
    const int lane = TIDX & 63, w = TIDX >> 6; bf16* U = (bf16*)(ws + WS_U); float* gklr = (float*)(ws + WS_GKLR);
    const int rbeg = blockIdx.x * 128 + w * 16;
    f32x4 va[4], vb[4]; load_row(in.x + (size_t)rbeg * D, lane, va); load_row(in.x + (size_t)(rbeg + 1) * D, lane, vb);
    for (int row = rbeg; row < rbeg + 16; row += 2) {
        const int rn = row + 2 < rbeg + 16 ? row + 2 : row; f32x4 na[4], nb[4]; load_row(in.x + (size_t)rn * D, lane, na); load_row(in.x + (size_t)(rn + 1) * D, lane, nb);
        float sa, sb; row_ssq2(va, vb, lane, sa, sb);
        const float ra = rsqrtf(sa * (1.f / D) + EPS), rb = rsqrtf(sb * (1.f / D) + EPS);
        store_row_bf16(U + (size_t)row * D, lane, va, ra); store_row_bf16(U + (size_t)(row + 1) * D, lane, vb, rb);
        const float pr = row_dots2<16>(va, vb, Wl, lane);
        if ((lane & 15) < 8) { const int cls = lane >> 4, col = 2 * (lane & 15) + (cls & 1); gklr[(size_t)(row + (cls >> 1)) * 16 + col] = pr * ((cls >> 1) ? rb : ra); }
#pragma unroll
        for (int j = 0; j < 4; ++j) { va[j] = na[j]; vb[j] = nb[j]; }
    }
}
struct TokRec { int e0, e1; float w0, w1; float rstd; int p0, p1; int pad; };
constexpr size_t WS_WGCNT = 511 * MiB;
typedef short rbf16x8 __attribute__((ext_vector_type(8)));
__device__ __forceinline__ void ph_router(const In& in, unsigned char* ws, const bf16* h, int layer, LAS unsigned char* lds) {
    constexpr int RSW = 2064;
    const float* gn = in.m_norm + layer * D; const float* wg = in.m_w_group + (size_t)layer * D * 4; const float* we = in.m_w_expert + (size_t)layer * D * NE;
    { f32x4 w4[2][5]; float gk[2];
#pragma unroll
      for (int q = 0; q < 2; ++q) { const int k = TIDX + 512 * q; gk[q] = gn[k]; w4[q][0] = *(const f32x4*)(wg + k * 4);
#pragma unroll
          for (int j = 0; j < 4; ++j) w4[q][1 + j] = *(const f32x4*)(we + k * NE + 4 * j); }
#pragma unroll
      for (int q = 0; q < 2; ++q) { const int k = TIDX + 512 * q;
#pragma unroll
          for (int c = 0; c < 20; ++c) { const float wv = gk[q] * w4[q][c >> 2][c & 3];
              const unsigned hi = f2bf(wv), lo = f2bf(wv - bf2f((unsigned short)hi)); *(LAS unsigned short*)(lds + c * RSW + k * 2) = (unsigned short)hi; *(LAS unsigned short*)(lds + (20 + c) * RSW + k * 2) = (unsigned short)lo; } } }
    for (int i = TIDX; i < 8 * 1024; i += 512) *(LAS unsigned short*)(lds + (40 + (i >> 10)) * RSW + (i & 1023) * 2) = 0;
    __syncthreads();
    const int lane = TIDX & 63, w = TIDX >> 6, r16 = lane & 15, kq = lane >> 4; TokRec* tok = (TokRec*)(ws + WS_TOK);
    LAS int* wcnt = (LAS int*)(lds + 48 * RSW); LAS float* lg = (LAS float*)(lds + 48 * RSW + 512) + w * (16 * 48);
    const float* bg = in.m_b_group + layer * 4; const float* be = in.m_b_expert + layer * NE;
    const int rowbase = blockIdx.x * 128 + w * 16;
    float rstd;
    { const bf16* hp = h + (size_t)(rowbase + r16) * D + 16 * kq;
      rbf16x8 a[32];
#pragma unroll
      for (int s = 0; s < 32; ++s) a[s] = *(const rbf16x8*)(hp + 64 * (s >> 1) + 8 * (s & 1));
      f32x4 acc[3]; acc[0] = (f32x4){0.f, 0.f, 0.f, 0.f}; acc[1] = acc[0]; acc[2] = acc[0]; float ssq = 0.f;
#pragma unroll
      for (int s = 0; s < 32; ++s) {
#pragma unroll
          for (int t = 0; t < 3; ++t) { const rbf16x8 B = *(const LAS rbf16x8*)(lds + (16 * t + r16) * RSW + (64 * (s >> 1) + 16 * kq + 8 * (s & 1)) * 2); acc[t] = __builtin_amdgcn_mfma_f32_16x16x32_bf16(a[s], B, acc[t], 0, 0, 0); }
          if ((s & 1) == 1) asm volatile("" ::: "memory");
          const v4u u = __builtin_bit_cast(v4u, a[s]);
          ssq += (bflo(u.x) * bflo(u.x) + bfhi(u.x) * bfhi(u.x)) + (bflo(u.y) * bflo(u.y) + bfhi(u.y) * bfhi(u.y)) + (bflo(u.z) * bflo(u.z) + bfhi(u.z) * bfhi(u.z)) + (bflo(u.w) * bflo(u.w) + bfhi(u.w) * bfhi(u.w)); }
      ssq += __shfl_xor(ssq, 16); ssq += __shfl_xor(ssq, 32);
      rstd = rsqrtf(ssq * (1.f / D) + EPS);
      { unsigned char* h8 = ws + WS_H8 + (size_t)(rowbase + r16) * D + 16 * kq; const float q8 = rstd * A8_SCALE;
#pragma unroll
        for (int s2 = 0; s2 < 16; ++s2) { v4u u = __builtin_bit_cast(v4u, a[2 * s2]), u2 = __builtin_bit_cast(v4u, a[2 * s2 + 1]); asm volatile("" : "+v"(u), "+v"(u2));
            v4u o; o.x = pg8::pk_fp8x4_nc(bflo(u.x) * q8, bfhi(u.x) * q8, bflo(u.y) * q8, bfhi(u.y) * q8); o.y = pg8::pk_fp8x4_nc(bflo(u.z) * q8, bfhi(u.z) * q8, bflo(u.w) * q8, bfhi(u.w) * q8);
            o.z = pg8::pk_fp8x4_nc(bflo(u2.x) * q8, bfhi(u2.x) * q8, bflo(u2.y) * q8, bfhi(u2.y) * q8); o.w = pg8::pk_fp8x4_nc(bflo(u2.z) * q8, bfhi(u2.z) * q8, bflo(u2.w) * q8, bfhi(u2.w) * q8);
            *(v4u*)(h8 + 64 * s2) = o; } }
#pragma unroll
      for (int t = 0; t < 3; ++t)
#pragma unroll
          for (int rg = 0; rg < 4; ++rg) lg[(4 * kq + rg) * 48 + 16 * t + r16] = acc[t][rg];
    }
    int re0, re1, rk0 = 0, rk1 = 0; float rw0, rw1, rrs; int cnt = 0;
    { const int ri = lane & 15; float p[20];
#pragma unroll
        for (int c = 0; c < 20; ++c) p[c] = lg[ri * 48 + c] + lg[ri * 48 + 20 + c];
        float gl[4]; int g = 0; float gmax;
#pragma unroll
        for (int c = 0; c < 4; ++c) gl[c] = p[c] * rstd + bg[c];
        gmax = gl[0];
#pragma unroll
        for (int c = 1; c < 4; ++c) if (gl[c] > gmax) { gmax = gl[c]; g = c; }
        float gsum = 0.f;
#pragma unroll
        for (int c = 0; c < 4; ++c) gsum += __expf(gl[c] - gmax);
        const float gw = 1.f / gsum;
        float sel[4];
#pragma unroll
        for (int j = 0; j < 4; ++j) { float s = p[4 + j] * rstd + be[j];
#pragma unroll
            for (int gg = 1; gg < 4; ++gg) { const float s2 = p[4 + 4 * gg + j] * rstd + be[4 * gg + j]; s = (g == gg) ? s2 : s; }
            sel[j] = s; }
        int i1 = 0; float s1 = sel[0];
#pragma unroll
        for (int j = 1; j < 4; ++j) if (sel[j] > s1) { s1 = sel[j]; i1 = j; }
        int i2 = -1; float s2 = -3.0e38f;
#pragma unroll
        for (int j = 0; j < 4; ++j) if (j != i1 && sel[j] > s2) { s2 = sel[j]; i2 = j; }
        const float r = __expf(s2 - s1), w1 = gw / (1.f + r), w2 = gw * r / (1.f + r);
        const int e0 = 4 * g + i1, e1 = 4 * g + i2;
        re0 = e0; re1 = e1; rw0 = w1; rw1 = w2; rrs = rstd;
#pragma unroll
        for (int e = 0; e < 16; ++e) { const unsigned long long m = __ballot(lane < 16 && (e0 == e || e1 == e)); const int below = __popcll(m & ((1ull << lane) - 1ull));
            rk0 = (e0 == e) ? below : rk0; rk1 = (e1 == e) ? below : rk1; cnt = (lane == e) ? (int)__popcll(m) : cnt; }
    }
    if (lane < 16) wcnt[w * 16 + lane] = cnt;
    __syncthreads();
    if (lane < 16) { int a0 = 0, a1 = 0;
        for (int ww = 0; ww < w; ++ww) { a0 += wcnt[ww * 16 + re0]; a1 += wcnt[ww * 16 + re1]; }
        TokRec t; t.e0 = re0; t.e1 = re1; t.w0 = rw0; t.w1 = rw1; t.rstd = rrs; t.p0 = a0 + rk0; t.p1 = a1 + rk1; t.pad = 0; tok[blockIdx.x * 128 + w * 16 + lane] = t; }
    if (TIDX < 16) { int tot = 0;
        for (int ww = 0; ww < 8; ++ww) tot += wcnt[ww * 16 + TIDX];
        ((int*)(ws + WS_WGCNT))[(layer * 256 + blockIdx.x) * 16 + TIDX] = tot; }
}
__device__ __forceinline__ void ph_positions(unsigned char* ws, int layer, LAS int* sm) {
    const int tid = TIDX; TokRec* tok = (TokRec*)(ws + WS_TOK);
    const int* wgc = (const int*)(ws + WS_WGCNT) + layer * 256 * 16; LAS int* tbl = sm; LAS int* part = sm + 4096; LAS int* basee = sm + 4096 + 512;
    { int v[8];
#pragma unroll
      for (int i = 0; i < 8; ++i) v[i] = wgc[tid + 512 * i];
#pragma unroll
      for (int i = 0; i < 8; ++i) tbl[tid + 512 * i] = v[i]; }
    __syncthreads();
    if (tid < 256) { const int e = tid & 15, seg = tid >> 4; int s = 0, bl = 0;
        for (int i = 0; i < 16; ++i) { const int blk = seg * 16 + i; const int v = tbl[blk * 16 + e]; s += v; bl += (blk < (int)blockIdx.x) ? v : 0; }
        part[tid] = s; part[256 + tid] = bl; }
    __syncthreads();
    if (tid < 16) { int tot = 0, bl = 0;
        for (int seg = 0; seg < 16; ++seg) { tot += part[seg * 16 + tid]; bl += part[256 + seg * 16 + tid]; }
        basee[16 + tid] = tot; basee[32 + tid] = bl; }
    __syncthreads();
    if (tid == 0) { int a = 0;
        for (int e = 0; e < 16; ++e) { basee[48 + e] = a; basee[e] = a + basee[32 + e]; a += ((basee[16 + e] + 255) >> 8) << 8; } }
    if (blockIdx.x == 0 && tid < 16) ((unsigned*)(ws + WS_CTL))[CW_CNT + 64 * layer + tid] = (unsigned)basee[16 + tid];
    __syncthreads();
    float* rs1 = (float*)(ws + WS_RS1); float* rs2 = (float*)(ws + WS_RS2); unsigned* rowoff = (unsigned*)(ws + WS_ROWOFF);
    { const int gi = blockIdx.x * 512 + tid; if (gi < XROWS) ((unsigned*)(ws + WS_ROWID))[gi] = (unsigned)gi * DE; }
    if (tid < 128) { const int row = blockIdx.x * 128 + tid; TokRec t = tok[row]; const int p0 = basee[t.e0] + t.p0, p1 = basee[t.e1] + t.p1;
        tok[row].p0 = p0; tok[row].p1 = p1; rowoff[p0] = (unsigned)row * D; rowoff[p1] = (unsigned)row * D; rs1[p0] = t.rstd; rs1[p1] = t.rstd; rs2[p0] = t.w0; rs2[p1] = t.w1; }
    if (blockIdx.x < 16) { const int e = blockIdx.x, tot = basee[16 + e], o = basee[48 + e], npad = (((tot + 255) >> 8) << 8) - tot;
        for (int i = tid; i < npad; i += 512) { rowoff[o + tot + i] = 0u; rs1[o + tot + i] = 0.f; rs2[o + tot + i] = 0.f; } }
}
__device__ __forceinline__ void ph_combine(const In& in, unsigned char* ws, float* out, int MODE) {
    const int lane = TIDX & 63, w = TIDX >> 6; const TokRec* tok = (const TokRec*)(ws + WS_TOK);
    const unsigned char* Y = ws + WS_Y; bf16* H = (bf16*)(ws + WS_H); float* rstd = (float*)(ws + WS_RSTD);
    const int rowbase = blockIdx.x * 128 + w * 16;
    int pp0 = 0, pp1 = 0; if (lane < 16) { pp0 = tok[rowbase + lane].p0; pp1 = tok[rowbase + lane].p1; }
    f32x4 gfin[4];
    if (MODE != 0) {
#pragma unroll
        for (int j = 0; j < 4; ++j) gfin[j] = *(const f32x4*)(in.final_norm + 256 * j + 4 * lane); }
    v2u ha[4], hb[4]; unsigned ya0[4], ya1[4], yb0[4], yb1[4];
#define COMBINE_LOAD(i16n) do { const int _r = rowbase + (i16n); const size_t _a0 = (size_t)__builtin_amdgcn_readlane(pp0, (i16n)) * D, _a1 = (size_t)__builtin_amdgcn_readlane(pp1, (i16n)) * D, _b0 = (size_t)__builtin_amdgcn_readlane(pp0, (i16n) + 1) * D, _b1 = (size_t)__builtin_amdgcn_readlane(pp1, (i16n) + 1) * D; \
        _Pragma("unroll") for (int j = 0; j < 4; ++j) { ha[j] = *(const v2u*)(H + (size_t)_r * D + 256 * j + 4 * lane); hb[j] = *(const v2u*)(H + (size_t)(_r + 1) * D + 256 * j + 4 * lane); } \
        _Pragma("unroll") for (int j = 0; j < 4; ++j) { ya0[j] = *(const unsigned*)(Y + _a0 + 256 * j + 4 * lane); ya1[j] = *(const unsigned*)(Y + _a1 + 256 * j + 4 * lane); yb0[j] = *(const unsigned*)(Y + _b0 + 256 * j + 4 * lane); yb1[j] = *(const unsigned*)(Y + _b1 + 256 * j + 4 * lane); } } while (0)
    COMBINE_LOAD(0);
#pragma unroll
    for (int i16 = 0; i16 < 16; i16 += 2) { const int row = rowbase + i16;
        f32x4 va[4], vb[4];
        typedef float f32x2v __attribute__((ext_vector_type(2)));
#pragma unroll
        for (int j = 0; j < 4; ++j) { const f32x2v a0l = __builtin_amdgcn_cvt_pk_f32_fp8((int)ya0[j], false), a0h = __builtin_amdgcn_cvt_pk_f32_fp8((int)ya0[j], true), a1l = __builtin_amdgcn_cvt_pk_f32_fp8((int)ya1[j], false), a1h = __builtin_amdgcn_cvt_pk_f32_fp8((int)ya1[j], true);
            const f32x2v b0l = __builtin_amdgcn_cvt_pk_f32_fp8((int)yb0[j], false), b0h = __builtin_amdgcn_cvt_pk_f32_fp8((int)yb0[j], true), b1l = __builtin_amdgcn_cvt_pk_f32_fp8((int)yb1[j], false), b1h = __builtin_amdgcn_cvt_pk_f32_fp8((int)yb1[j], true);
            va[j].x = bflo(ha[j].x) + (a0l.x + a1l.x) * 0.0625f; va[j].y = bfhi(ha[j].x) + (a0l.y + a1l.y) * 0.0625f; va[j].z = bflo(ha[j].y) + (a0h.x + a1h.x) * 0.0625f; va[j].w = bfhi(ha[j].y) + (a0h.y + a1h.y) * 0.0625f;
            vb[j].x = bflo(hb[j].x) + (b0l.x + b1l.x) * 0.0625f; vb[j].y = bfhi(hb[j].x) + (b0l.y + b1l.y) * 0.0625f; vb[j].z = bflo(hb[j].y) + (b0h.x + b1h.x) * 0.0625f; vb[j].w = bfhi(hb[j].y) + (b0h.y + b1h.y) * 0.0625f; }
        if (i16 + 2 < 16) COMBINE_LOAD(i16 + 2);
        float sa, sb; row_ssq2(va, vb, lane, sa, sb);
        const float ra = rsqrtf(sa * (1.f / D) + EPS), rb = rsqrtf(sb * (1.f / D) + EPS);
        if (MODE == 0) {
            store_row_bf16(H + (size_t)row * D, lane, va, 1.f); store_row_bf16(H + (size_t)(row + 1) * D, lane, vb, 1.f);
            if (lane == 0) { rstd[row] = ra; rstd[row + 1] = rb; }
        } else {
#pragma unroll
            for (int j = 0; j < 4; ++j) { const f32x4 g = gfin[j];
                f32x4 oa, ob; oa.x = va[j].x * ra * g.x; oa.y = va[j].y * ra * g.y; oa.z = va[j].z * ra * g.z; oa.w = va[j].w * ra * g.w; ob.x = vb[j].x * rb * g.x; ob.y = vb[j].y * rb * g.y; ob.z = vb[j].z * rb * g.z; ob.w = vb[j].w * rb * g.w;
                *(f32x4*)(out + (size_t)row * D + 256 * j + 4 * lane) = oa; *(f32x4*)(out + (size_t)(row + 1) * D + 256 * j + 4 * lane) = ob; }
        }
    }
#undef COMBINE_LOAD
}
__device__ __forceinline__ void build_tile_prefix(const unsigned* cnt, LAS int* tp) {
    if (TIDX < 64) { const int lane = TIDX; const int tiles = lane < 16 ? (((int)cnt[lane & 15] + 255) >> 8) : 0; int incl = tiles;
#pragma unroll
        for (int o = 1; o < 16; o <<= 1) { const int v = __shfl_up(incl, o); incl += (lane >= o) ? v : 0; }
        if (lane < 16) tp[lane] = incl - tiles;
        if (lane == 15) tp[16] = incl; }
    __syncthreads();
}
typedef short bf16x8 __attribute__((ext_vector_type(8)));
typedef short s16x4 __attribute__((ext_vector_type(4)));
typedef short v4i16_t __attribute__((ext_vector_type(4)));
typedef float f32x16 __attribute__((ext_vector_type(16)));
typedef float f32x2_t __attribute__((ext_vector_type(2)));
typedef __bf16 bf16x2_t __attribute__((ext_vector_type(2)));
#define MFMA32(a, b, c) __builtin_amdgcn_mfma_f32_32x32x16_bf16((a), (b), (c), 0, 0, 0)
__device__ __forceinline__ unsigned cvtpk(float lo, float hi) { f32x2_t v = {lo, hi}; return __builtin_bit_cast(unsigned, __builtin_convertvector(v, bf16x2_t)); }
__device__ __forceinline__ s16x4 vtr(const LAS unsigned char* p) { return __builtin_bit_cast(s16x4, __builtin_amdgcn_ds_read_tr16_b64_v4i16((LAS v4i16_t*)p)); }
__device__ __forceinline__ bf16x8 cat4(s16x4 a, s16x4 b) { bf16x8 r; r[0] = a[0]; r[1] = a[1]; r[2] = a[2]; r[3] = a[3]; r[4] = b[0]; r[5] = b[1]; r[6] = b[2]; r[7] = b[3]; return r; }
__device__ __forceinline__ bf16x8 pack8(const f32x16& x, int s) {
    v4u p; p.x = cvtpk(x[8 * s], x[8 * s + 1]); p.y = cvtpk(x[8 * s + 2], x[8 * s + 3]); p.z = cvtpk(x[8 * s + 4], x[8 * s + 5]); p.w = cvtpk(x[8 * s + 6], x[8 * s + 7]); return __builtin_bit_cast(bf16x8, p); }
__device__ __forceinline__ f32x16 zero16() { f32x16 z;
#pragma unroll
    for (int i = 0; i < 16; ++i) z[i] = 0.f; return z; }
#define LDSBAR() do { asm volatile("s_waitcnt lgkmcnt(0)" ::: "memory"); __builtin_amdgcn_s_barrier(); asm volatile("" ::: "memory"); } while (0)
constexpr size_t WS_DEC = 510 * MiB;
constexpr size_t WS_B = 50 * MiB;
constexpr int RS_P = 272, RS_T = 320, RS_V = 576;
typedef float f32x2g __attribute__((ext_vector_type(2)));
__device__ __forceinline__ void gla_gates(const f32x4 gk_piece, const f32x2g (&w2)[GR / 2], const float bias, LAS float* sm_gklr, LAS float* sm_qt, float (&bq)[16], float& blast) {
    const int tid = TIDX, d = tid & 127, qtr = tid >> 7;
    if (tid < 256) *(LAS f32x4*)(sm_gklr + 4 * tid) = gk_piece;
    typedef float f32x2v __attribute__((ext_vector_type(2)));
    LDSBAR();
    float run = 0.f;
#pragma unroll
    for (int i = 0; i < 16; ++i) { const int c = 16 * qtr + i; f32x2v xa = {bias, 0.f};
#pragma unroll
        for (int r4 = 0; r4 < 4; ++r4) { const f32x4 g = *(const LAS f32x4*)(sm_gklr + c * 16 + 4 * r4); const f32x2v gl = {g.x, g.y}, gh = {g.z, g.w}; xa += gl * w2[2 * r4]; xa += gh * w2[2 * r4 + 1]; }
        const float x = xa.x + xa.y;
        run += (fminf(x, 0.f) - __logf(1.f + __expf(-fabsf(x)))) * (1.f / 16.f); bq[i] = run; }
    sm_qt[qtr * 128 + d] = run;
    LDSBAR();
    float off = 0.f, tot = 0.f;
#pragma unroll
    for (int q = 0; q < 4; ++q) { const float v = sm_qt[q * 128 + d]; off += (q < qtr) ? v : 0.f; tot += v; }
#pragma unroll
    for (int i = 0; i < 16; ++i) bq[i] += off;
    blast = tot;
}
__device__ __forceinline__ void stage_v(const bf16* vsrc, LAS unsigned char* imgV) {
#pragma unroll
    for (int i = 0; i < 4; ++i) { const int ch = TIDX + 512 * i, r = ch >> 5, cc = ch & 31; *(LAS v4u*)(imgV + r * RS_V + cc * 16) = *(const v4u*)(vsrc + (size_t)r * NPROJ + cc * 8); }
}
__device__ __forceinline__ bf16x8 tr_frag(const LAS unsigned char* img, int RS, int rowA, int rowB, int col0, int lane) {
    const int q = (lane & 15) >> 2, cb = (col0 + 16 * ((lane >> 4) & 1) + 4 * (lane & 3)) * 2;
    return cat4(vtr(img + (rowA + q) * RS + cb), vtr(img + (rowB + q) * RS + cb));
}
__device__ __forceinline__ int prev_off(int row, int ch) { return row * 128 + ((ch ^ ((row >> 1) & 7)) << 4); }
__device__ __forceinline__ void gla_g3_super(const In& in, unsigned char* ws, LAS unsigned char* lds, int sunit) {
    const int unit0 = (sunit >> 4) * 64 + (sunit & 15) * 4;
    f32x16 Sacc[4];
    { const int lane_ = TIDX & 63, wave_ = TIDX >> 6, hh_ = lane_ >> 5, r_ = lane_ & 31; const bf16* prev0 = (const bf16*)(ws + WS_ST) + (size_t)sunit * (DV * DK) + (size_t)(32 * wave_ + r_) * DK;
#pragma unroll
      for (int t = 0; t < 4; ++t)
#pragma unroll
          for (int g = 0; g < 4; ++g) { const v2u pv = *(const v2u*)(prev0 + 32 * t + 8 * g + 4 * hh_); Sacc[t][4 * g] = bflo(pv.x); Sacc[t][4 * g + 1] = bfhi(pv.x); Sacc[t][4 * g + 2] = bflo(pv.y); Sacc[t][4 * g + 3] = bfhi(pv.y); } }
    typedef _Float16 h8 __attribute__((ext_vector_type(8)));
    v4u qraw[2], kraw[2], vraw[4]; h8 braw[2];
    { const int tid = TIDX, hd0 = (unit0 >> 6) & 3; const size_t row00 = (size_t)(unit0 >> 8) * SEQ + (unit0 & 63) * CH; const bf16* proj0 = (const bf16*)(ws + WS_PROJ) + row00 * NPROJ; const _Float16* bin0 = (const _Float16*)(ws + WS_B) + row00 * QKD + hd0 * DK;
#pragma unroll
      for (int i = 0; i < 2; ++i) { const int ch = tid + 512 * i, c = ch >> 4, d0 = (ch & 15) * 8; qraw[i] = *(const v4u*)(proj0 + (size_t)c * NPROJ + hd0 * DK + d0); kraw[i] = *(const v4u*)(proj0 + (size_t)c * NPROJ + QKD + hd0 * DK + d0); braw[i] = *(const h8*)(bin0 + (size_t)c * QKD + d0); }
#pragma unroll
      for (int i = 0; i < 4; ++i) { const int ch = tid + 512 * i; vraw[i] = *(const v4u*)(proj0 + 1024 + hd0 * DV + (size_t)(ch >> 5) * NPROJ + (ch & 31) * 8); } }
#pragma unroll 1
    for (int jsub = 0; jsub < 4; ++jsub) { const int unit = unit0 + jsub;
    const int tid = TIDX, lane = tid & 63, wave = tid >> 6, hh = lane >> 5, r = lane & 31, d = tid & 127, qtr = tid >> 7;
    const int n = unit & 63, hd = (unit >> 6) & 3, b = unit >> 8; const size_t row0 = (size_t)b * SEQ + n * CH;
    const bf16* proj = (const bf16*)(ws + WS_PROJ) + row0 * NPROJ;
    LAS float* sm_ssq = (LAS float*)(lds + 6144);
    LAS unsigned char* imgQ = lds + 8192; LAS unsigned char* imgK = imgQ + 64 * RS_P; LAS unsigned char* imgV = imgK + 64 * RS_P; LAS unsigned char* imgS = imgV + 64 * RS_V; LAS unsigned char* imgO = lds + 8192;
    const int ib = wave & 1, dg = wave >> 1;
    LAS float* sm_dec = (LAS float*)(lds + 4096);
    { const _Float16* bin = (const _Float16*)(ws + WS_B) + row0 * QKD + hd * DK; f32x4 b0[2], b1[2];
#pragma unroll
      for (int i = 0; i < 2; ++i) { const h8 bb = braw[i]; b0[i] = (f32x4){(float)bb[0], (float)bb[1], (float)bb[2], (float)bb[3]}; b1[i] = (f32x4){(float)bb[4], (float)bb[5], (float)bb[6], (float)bb[7]}; }
#pragma unroll
      for (int i = 0; i < 2; ++i) { const int ch = tid + 512 * i, c = ch >> 4, d0 = (ch & 15) * 8;
        const float e0 = __expf(b0[i].x), e1 = __expf(b0[i].y), e2 = __expf(b0[i].z), e3 = __expf(b0[i].w), e4 = __expf(b1[i].x), e5 = __expf(b1[i].y), e6 = __expf(b1[i].z), e7 = __expf(b1[i].w);
        v4u qo, ko; const v4u q = qraw[i], k = kraw[i];
        qo.x = cvtpk(bflo(q.x) * e0, bfhi(q.x) * e1); qo.y = cvtpk(bflo(q.y) * e2, bfhi(q.y) * e3); qo.z = cvtpk(bflo(q.z) * e4, bfhi(q.z) * e5); qo.w = cvtpk(bflo(q.w) * e6, bfhi(q.w) * e7);
        ko.x = cvtpk(bflo(k.x) * __builtin_amdgcn_rcpf(e0), bfhi(k.x) * __builtin_amdgcn_rcpf(e1)); ko.y = cvtpk(bflo(k.y) * __builtin_amdgcn_rcpf(e2), bfhi(k.y) * __builtin_amdgcn_rcpf(e3));
        ko.z = cvtpk(bflo(k.z) * __builtin_amdgcn_rcpf(e4), bfhi(k.z) * __builtin_amdgcn_rcpf(e5)); ko.w = cvtpk(bflo(k.w) * __builtin_amdgcn_rcpf(e6), bfhi(k.w) * __builtin_amdgcn_rcpf(e7));
        *(LAS v4u*)(imgQ + c * RS_P + d0 * 2) = qo; *(LAS v4u*)(imgK + c * RS_P + d0 * 2) = ko;
        if (c == 63) { *(LAS f32x4*)(sm_dec + d0) = (f32x4){e0, e1, e2, e3}; *(LAS f32x4*)(sm_dec + d0 + 4) = (f32x4){e4, e5, e6, e7}; } }
#pragma unroll
      for (int i = 0; i < 4; ++i) { const int ch = tid + 512 * i; *(LAS v4u*)(imgV + (ch >> 5) * RS_V + (ch & 31) * 16) = vraw[i]; }
      if (jsub < 3) { const bf16* projn = proj + (size_t)CH * NPROJ; const _Float16* binn = bin + (size_t)CH * QKD;
#pragma unroll
        for (int i = 0; i < 2; ++i) { const int ch = tid + 512 * i, c = ch >> 4, d0 = (ch & 15) * 8; qraw[i] = *(const v4u*)(projn + (size_t)c * NPROJ + hd * DK + d0); kraw[i] = *(const v4u*)(projn + (size_t)c * NPROJ + QKD + hd * DK + d0); braw[i] = *(const h8*)(binn + (size_t)c * QKD + d0); }
#pragma unroll
        for (int i = 0; i < 4; ++i) { const int ch = tid + 512 * i; vraw[i] = *(const v4u*)(projn + 1024 + hd * DV + (size_t)(ch >> 5) * NPROJ + (ch & 31) * 8); } } }
#pragma unroll
    for (int t = 0; t < 2; ++t)
#pragma unroll
        for (int g = 0; g < 4; ++g) { v2u o; o.x = cvtpk(Sacc[t][4 * g], Sacc[t][4 * g + 1]); o.y = cvtpk(Sacc[t][4 * g + 2], Sacc[t][4 * g + 3]); *(LAS v2u*)(imgS + prev_off(32 * wave + r, 4 * t + g) + 8 * hh) = o; }
    LDSBAR();
    bf16x8 qf[8];
#pragma unroll
    for (int s = 0; s < 8; ++s) qf[s] = *(const LAS bf16x8*)(imgQ + (32 * ib + r) * RS_P + (16 * s + 8 * hh) * 2);
    f32x16 acc[2]; acc[0] = zero16(); acc[1] = zero16();
#pragma unroll
    for (int jb = 0; jb < 2; ++jb) {
        if (jb <= ib) {
            f32x16 att = zero16();
#pragma unroll
            for (int s = 0; s < 8; ++s) { const bf16x8 A = *(const LAS bf16x8*)(imgK + (32 * jb + r) * RS_P + (16 * s + 8 * hh) * 2); att = MFMA32(A, qf[s], att); }
            if (jb == ib) {
#pragma unroll
                for (int i = 0; i < 16; ++i) { const int j = (i & 3) + 8 * (i >> 2) + 4 * hh; att[i] = (j > r) ? 0.f : att[i]; } }
#pragma unroll
            for (int s2 = 0; s2 < 2; ++s2) { const bf16x8 P = pack8(att, s2); const int ra = 32 * jb + 16 * s2 + 4 * hh, rb = ra + 8;
#pragma unroll
                for (int t = 0; t < 2; ++t) { const bf16x8 A = tr_frag(imgV, RS_V, ra, rb, 64 * dg + 32 * t, lane); acc[t] = MFMA32(A, P, acc[t]); } }
        }
    }
#pragma unroll
    for (int s = 0; s < 4; ++s)
#pragma unroll
        for (int t = 0; t < 2; ++t) { const bf16x8 A = *(const LAS bf16x8*)(imgS + prev_off(64 * dg + 32 * t + r, 2 * s + hh)); acc[t] = MFMA32(A, qf[s], acc[t]); }
    LDSBAR();
#pragma unroll
    for (int t = 0; t < 2; ++t)
#pragma unroll
        for (int g = 0; g < 4; ++g) { v2u o; o.x = cvtpk(Sacc[2 + t][4 * g], Sacc[2 + t][4 * g + 1]); o.y = cvtpk(Sacc[2 + t][4 * g + 2], Sacc[2 + t][4 * g + 3]); *(LAS v2u*)(imgS + prev_off(32 * wave + r, 4 * t + g) + 8 * hh) = o; }
    LDSBAR();
#pragma unroll
    for (int s = 0; s < 4; ++s)
#pragma unroll
        for (int t = 0; t < 2; ++t) { const bf16x8 A = *(const LAS bf16x8*)(imgS + prev_off(64 * dg + 32 * t + r, 2 * s + hh)); acc[t] = MFMA32(A, qf[4 + s], acc[t]); }
    v4u graw[4];
#pragma unroll
    for (int i = 0; i < 4; ++i) { const int ch = tid + 512 * i; graw[i] = *(const v4u*)(proj + 2048 + hd * DV + (size_t)(ch >> 5) * NPROJ + (ch & 31) * 8); }
#pragma unroll
    for (int s = 0; s < 4; ++s) { const int ra = 16 * s + 8 * hh, rb = ra + 4; const bf16x8 Bv = tr_frag(imgV, RS_V, ra, rb, 32 * wave, lane);
#pragma unroll
        for (int t = 0; t < 4; ++t) Sacc[t] = MFMA32(tr_frag(imgK, RS_P, ra, rb, 32 * t, lane), Bv, Sacc[t]); }
#pragma unroll
    for (int t = 0; t < 4; ++t)
#pragma unroll
        for (int i = 0; i < 16; ++i) Sacc[t][i] *= sm_dec[32 * t + (i & 3) + 8 * (i >> 2) + 4 * hh];
    float ssq = 0.f;
#pragma unroll
    for (int t = 0; t < 2; ++t)
#pragma unroll
        for (int i = 0; i < 16; ++i) ssq += acc[t][i] * acc[t][i];
    ssq += __shfl_xor(ssq, 32);
    if (hh == 0) sm_ssq[(ib * 4 + dg) * 32 + r] = ssq;
    LDSBAR();
    const float tot = (sm_ssq[(ib * 4 + 0) * 32 + r] + sm_ssq[(ib * 4 + 1) * 32 + r]) + (sm_ssq[(ib * 4 + 2) * 32 + r] + sm_ssq[(ib * 4 + 3) * 32 + r]);
    const float rstd = rsqrtf(tot * (1.f / DV) + EPS);
#pragma unroll
    for (int t = 0; t < 2; ++t)
#pragma unroll
        for (int g = 0; g < 4; ++g) { v2u o; o.x = cvtpk(acc[t][4 * g] * rstd, acc[t][4 * g + 1] * rstd); o.y = cvtpk(acc[t][4 * g + 2] * rstd, acc[t][4 * g + 3] * rstd);
            *(LAS v2u*)(imgO + (32 * ib + r) * 520 + (64 * dg + 32 * t + 8 * g + 4 * hh) * 2) = o; }
    LDSBAR();
    bf16* og = (bf16*)(ws + WS_U) + row0 * D + hd * DV;
#pragma unroll
    for (int i = 0; i < 4; ++i) { const int ch = tid + 512 * i, row = ch >> 5, cc = ch & 31;
        const v2u a = *(const LAS v2u*)(imgO + row * 520 + cc * 16), b2 = *(const LAS v2u*)(imgO + row * 520 + cc * 16 + 8);
        const v4u gg = graw[i];
        v4u o; o.x = cvtpk(bflo(a.x) * pg8::silu_f(bflo(gg.x)), bfhi(a.x) * pg8::silu_f(bfhi(gg.x))); o.y = cvtpk(bflo(a.y) * pg8::silu_f(bflo(gg.y)), bfhi(a.y) * pg8::silu_f(bfhi(gg.y)));
        o.z = cvtpk(bflo(b2.x) * pg8::silu_f(bflo(gg.z)), bfhi(b2.x) * pg8::silu_f(bfhi(gg.z))); o.w = cvtpk(bflo(b2.y) * pg8::silu_f(bflo(gg.w)), bfhi(b2.y) * pg8::silu_f(bfhi(gg.w)));
        *(v4u*)(og + (size_t)row * D + cc * 8) = o; }
    LDSBAR();
    }
}

__device__ __forceinline__ void gla_g1_super(const In& in, unsigned char* ws, LAS unsigned char* lds, int sunit) {
    const int tid = TIDX, lane = tid & 63, wave = tid >> 6, hh = lane >> 5, r = lane & 31, d = tid & 127, qtr = tid >> 7;
    const int unit0 = (sunit >> 4) * 64 + (sunit & 15) * 4; const int mb = wave & 3, ng = wave >> 2;
    LAS float* sm_dec = (LAS float*)(lds + 6144);
    f32x16 acc[4];
#pragma unroll
    for (int t = 0; t < 4; ++t) acc[t] = zero16();
    float decprod = 1.f;
    unsigned short kraw[16]; v4u vraw[4]; f32x4 gkp = {0.f, 0.f, 0.f, 0.f}; f32x2g w2[GR / 2]; float bias;
    { const int hd0 = (unit0 >> 6) & 3; const size_t row00 = (size_t)(unit0 >> 8) * SEQ + (unit0 & 63) * CH; const bf16* proj0 = (const bf16*)(ws + WS_PROJ) + row00 * NPROJ;
      if (tid < 256) gkp = *(const f32x4*)((const float*)(ws + WS_GKLR) + row00 * 16 + 4 * tid);
#pragma unroll
      for (int i = 0; i < 16; ++i) kraw[i] = proj0[(size_t)(16 * qtr + i) * NPROJ + QKD + hd0 * DK + d];
#pragma unroll
      for (int i = 0; i < 4; ++i) { const int ch = tid + 512 * i; vraw[i] = *(const v4u*)(proj0 + 1024 + hd0 * DV + (size_t)(ch >> 5) * NPROJ + (ch & 31) * 8); }
#pragma unroll
      for (int r = 0; r < GR / 2; ++r) { w2[r].x = in.a_w_gk2[(2 * r) * QKD + hd0 * DK + d]; w2[r].y = in.a_w_gk2[(2 * r + 1) * QKD + hd0 * DK + d]; }
      bias = in.a_b_gk2[hd0 * DK + d]; }
#pragma unroll 1
    for (int jsub = 0; jsub < 4; ++jsub) { const int unit = unit0 + jsub;
    const int n = unit & 63, hd = (unit >> 6) & 3, b = unit >> 8; const size_t row0 = (size_t)b * SEQ + n * CH;
    const bf16* proj = (const bf16*)(ws + WS_PROJ) + row0 * NPROJ;
    LAS float* sm_gklr = (LAS float*)lds; LAS float* sm_qt = (LAS float*)(lds + 4096); LAS unsigned char* imgK = lds + 8192; LAS unsigned char* imgV = lds + 8192 + 64 * RS_T;
    float bq[16], blast; gla_gates(gkp, w2, bias, sm_gklr, sm_qt, bq, blast);
    _Float16* bout = (_Float16*)(ws + WS_B) + row0 * QKD + hd * DK + d;
#pragma unroll
    for (int i = 0; i < 16; ++i) { const int c = 16 * qtr + i; bout[(size_t)c * QKD] = (_Float16)bq[i]; *(LAS unsigned short*)(imgK + c * RS_T + d * 2) = (unsigned short)f2bf(bf2f(kraw[i]) * __expf(blast - bq[i])); }
    if (qtr == 0) { const float dj = __expf(blast); sm_dec[d] = dj; decprod *= dj; }
#pragma unroll
    for (int i = 0; i < 4; ++i) { const int ch = tid + 512 * i; *(LAS v4u*)(imgV + (ch >> 5) * RS_V + (ch & 31) * 16) = vraw[i]; }
    if (jsub < 3) { const bf16* projn = proj + (size_t)CH * NPROJ;
      if (tid < 256) gkp = *(const f32x4*)((const float*)(ws + WS_GKLR) + (row0 + CH) * 16 + 4 * tid);
#pragma unroll
      for (int i = 0; i < 16; ++i) kraw[i] = projn[(size_t)(16 * qtr + i) * NPROJ + QKD + hd * DK + d];
#pragma unroll
      for (int i = 0; i < 4; ++i) { const int ch = tid + 512 * i; vraw[i] = *(const v4u*)(projn + 1024 + hd * DV + (size_t)(ch >> 5) * NPROJ + (ch & 31) * 8); } }
    LDSBAR();
#pragma unroll
    for (int t = 0; t < 4; ++t)
#pragma unroll
        for (int i = 0; i < 16; ++i) acc[t][i] *= sm_dec[32 * mb + (i & 3) + 8 * (i >> 2) + 4 * hh];
#pragma unroll
    for (int s = 0; s < 4; ++s) { const int ra = 16 * s + 8 * hh, rb = ra + 4;
        const bf16x8 A = tr_frag(imgK, RS_T, ra, rb, 32 * mb, lane);
#pragma unroll
        for (int t = 0; t < 4; ++t) { const bf16x8 B = tr_frag(imgV, RS_V, ra, rb, 32 * (4 * ng + t), lane); acc[t] = MFMA32(A, B, acc[t]); } }
    LDSBAR();
    }
    LAS unsigned char* imgO = lds + 8192;
#pragma unroll
    for (int t = 0; t < 4; ++t) { const int dv = 32 * (4 * ng + t) + r;
#pragma unroll
        for (int g = 0; g < 4; ++g) { v2u o; o.x = cvtpk(acc[t][4 * g], acc[t][4 * g + 1]); o.y = cvtpk(acc[t][4 * g + 2], acc[t][4 * g + 3]); *(LAS v2u*)(imgO + dv * 264 + (32 * mb + 8 * g + 4 * hh) * 2) = o; } }
    LDSBAR();
    bf16* upd = (bf16*)(ws + WS_ST) + (size_t)sunit * (DV * DK);
    if (qtr == 0) ((float*)(ws + WS_DEC))[(size_t)sunit * DK + d] = decprod;
#pragma unroll
    for (int i = 0; i < 8; ++i) { const int ch = tid + 512 * i, row = ch >> 4, cc = ch & 15; v2u a = *(const LAS v2u*)(imgO + row * 264 + cc * 16), b2 = *(const LAS v2u*)(imgO + row * 264 + cc * 16 + 8);
        v4u o; o.x = a.x; o.y = a.y; o.z = b2.x; o.w = b2.y; *(v4u*)(upd + (size_t)row * DK + cc * 8) = o; }
    LDSBAR();
}

__device__ __forceinline__ void gla_g2_super(unsigned char* ws, LAS float* sdec) {
    const int tid = TIDX, gid = blockIdx.x * 512 + tid;
    const int bh = (blockIdx.x * 512) >> 12, e8 = gid & 4095, dk0 = (e8 * 8) & 127;
    { const float* dsrc = (const float*)(ws + WS_DEC) + (size_t)bh * 16 * DK;
      *(LAS f32x4*)(sdec + 4 * tid) = *(const f32x4*)(dsrc + 4 * tid); }
    LDSBAR();
    bf16* base = (bf16*)(ws + WS_ST) + (size_t)bh * 16 * (DV * DK) + e8 * 8;
    float S[8];
#pragma unroll
    for (int j = 0; j < 8; ++j) S[j] = 0.f;
    for (int n0 = 0; n0 < NCH / 4; n0 += 16) {
        v4u u[16];
#pragma unroll
        for (int i = 0; i < 16; ++i) u[i] = *(const v4u*)(base + (size_t)(n0 + i) * (DV * DK));
#pragma unroll
        for (int i = 0; i < 16; ++i) { const f32x4 da = *(const LAS f32x4*)(sdec + (n0 + i) * DK + dk0), db = *(const LAS f32x4*)(sdec + (n0 + i) * DK + dk0 + 4);
            v4u o; o.x = cvtpk(S[0], S[1]); o.y = cvtpk(S[2], S[3]); o.z = cvtpk(S[4], S[5]); o.w = cvtpk(S[6], S[7]); *(v4u*)(base + (size_t)(n0 + i) * (DV * DK)) = o;
            S[0] = da.x * S[0] + bflo(u[i].x); S[1] = da.y * S[1] + bfhi(u[i].x); S[2] = da.z * S[2] + bflo(u[i].y); S[3] = da.w * S[3] + bfhi(u[i].y);
            S[4] = db.x * S[4] + bflo(u[i].z); S[5] = db.y * S[5] + bfhi(u[i].z); S[6] = db.z * S[6] + bflo(u[i].w); S[7] = db.w * S[7] + bfhi(u[i].w); }
    }
}
constexpr int RS_SV = 192, RS_SK = 144, SB_WAVE_LDS = 32 * RS_SV + 32 * RS_SK;
__device__ __forceinline__ float softplus_fast(float z) { return fmaxf(z, 0.f) + __logf(1.f + __expf(-fabsf(z))); }
__device__ __forceinline__ bool sb_block(LAS unsigned char* imgK, LAS unsigned char* imgV, const bf16x8 (&qf)[4], const v4u (&kv)[4], const v4u (&vv)[4], f32x16& o0, f32x16& o1, float& R, float& carry, bool diag, int lane) {
    const int hh = lane >> 5, r = lane & 31, lrow = lane >> 3, lch = lane & 7;
#pragma unroll
    for (int s = 0; s < 4; ++s) { *(LAS v4u*)(imgK + (8 * s + lrow) * RS_SK + lch * 16) = kv[s]; *(LAS v4u*)(imgV + (8 * s + lrow) * RS_SV + lch * 16) = vv[s]; }
    bf16x8 kf[4];
#pragma unroll
    for (int s = 0; s < 4; ++s) kf[s] = *(const LAS bf16x8*)(imgK + r * RS_SK + 64 * hh + 16 * s);
    f32x16 z = zero16();
#pragma unroll
    for (int s = 0; s < 4; ++s) z = MFMA32(kf[s], qf[s], z);
    float om[16], be[16];
    if (diag) {
#pragma unroll
        for (int i = 0; i < 16; ++i) { const int keyl = (i & 3) + 8 * (i >> 2) + 4 * hh; const float o_ = __builtin_amdgcn_rcpf(1.f + __builtin_amdgcn_exp2f(z[i])); const bool valid = keyl < r; om[i] = valid ? o_ : 1.f; be[i] = valid ? 1.f - o_ : 0.f; }
    } else {
#pragma unroll
        for (int i = 0; i < 16; ++i) { om[i] = __builtin_amdgcn_rcpf(1.f + __builtin_amdgcn_exp2f(z[i])); be[i] = 1.f - om[i]; }
    }
    float pr[4], Tg[4];
#pragma unroll
    for (int g = 0; g < 4; ++g) { const float rg = (om[4 * g] * om[4 * g + 1]) * (om[4 * g + 2] * om[4 * g + 3]); pr[g] = __shfl_xor(rg, 32); Tg[g] = rg * pr[g]; }
    float off[4]; off[3] = carry; off[2] = carry * Tg[3]; off[1] = off[2] * Tg[2]; off[0] = off[1] * Tg[1];
    if (hh == 0) {
#pragma unroll
        for (int g = 0; g < 4; ++g) off[g] *= pr[g]; }
    f32x16 a;
#pragma unroll
    for (int g = 0; g < 4; ++g) { const float w2 = om[4 * g + 3], w1 = w2 * om[4 * g + 2], w0 = w1 * om[4 * g + 1];
        a[4 * g] = be[4 * g] * (off[g] * w0); a[4 * g + 1] = be[4 * g + 1] * (off[g] * w1); a[4 * g + 2] = be[4 * g + 2] * (off[g] * w2); a[4 * g + 3] = be[4 * g + 3] * off[g]; }
    R -= __builtin_amdgcn_logf((Tg[0] * Tg[1]) * (Tg[2] * Tg[3]));
    carry = __builtin_amdgcn_exp2f(-R);
#pragma unroll
    for (int s2 = 0; s2 < 2; ++s2) { const bf16x8 P = pack8(a, s2); const int ra = 16 * s2 + 4 * hh, rb = ra + 8;
        o0 = MFMA32(tr_frag(imgV, RS_SV, ra, rb, 0, lane), P, o0); o1 = MFMA32(tr_frag(imgV, RS_SV, ra, rb, 32, lane), P, o1); }
    return __all(R > 150.5f);
}
__device__ __forceinline__ void sb_load_kv(const bf16* base, int kb, int lane, v4u (&kv)[4], v4u (&vv)[4]) {
    const bf16* kp = base + 1024 + (size_t)(kb * 32 + (lane >> 3)) * NPROJ + (lane & 7) * 8;
#pragma unroll
    for (int s = 0; s < 4; ++s) { kv[s] = *(const v4u*)(kp + (size_t)(8 * s) * NPROJ); vv[s] = *(const v4u*)(kp + 1024 + (size_t)(8 * s) * NPROJ); }
}
__device__ __forceinline__ void sb_attn_task(unsigned char* ws, LAS unsigned char* imgV, int task, int lane) {
    LAS unsigned char* imgK = imgV + 32 * RS_SV;
    const int hh = lane >> 5, r = lane & 31, qb = task & 127, bh = task >> 7, hd = bh & 15, b = bh >> 4, lrow = lane >> 3, lch = lane & 7;
    const bf16* base = (const bf16*)(ws + WS_PROJ) + (size_t)b * SEQ * NPROJ + hd * SBD;
    bf16x8 qf[4];
    { const bf16* qrow = base + (size_t)(qb * 32 + r) * NPROJ + 32 * hh;
#pragma unroll
      for (int s = 0; s < 4; ++s) qf[s] = *(const bf16x8*)(qrow + 8 * s); }
    f32x16 o0 = zero16(), o1 = zero16(); float R = 0.f, carry = 1.f;
    v4u ka[4], va[4], kb4[4], vb4[4];
    sb_load_kv(base, qb, lane, ka, va);
    for (int kb = qb;;) {
        sb_load_kv(base, kb > 0 ? kb - 1 : 0, lane, kb4, vb4);
        if (sb_block(imgK, imgV, qf, ka, va, o0, o1, R, carry, kb == qb, lane) || kb == 0) break;
        --kb;
        sb_load_kv(base, kb > 0 ? kb - 1 : 0, lane, ka, va);
        if (sb_block(imgK, imgV, qf, kb4, vb4, o0, o1, R, carry, false, lane) || kb == 0) break;
        --kb;
    }
#pragma unroll
    for (int g = 0; g < 4; ++g) { v2u w; w.x = cvtpk(o0[4 * g], o0[4 * g + 1]); w.y = cvtpk(o0[4 * g + 2], o0[4 * g + 3]); *(LAS v2u*)(imgK + r * RS_SK + (8 * g + 4 * hh) * 2) = w;
        v2u w2; w2.x = cvtpk(o1[4 * g], o1[4 * g + 1]); w2.y = cvtpk(o1[4 * g + 2], o1[4 * g + 3]); *(LAS v2u*)(imgK + r * RS_SK + (32 + 8 * g + 4 * hh) * 2) = w2; }
    bf16* obase = (bf16*)(ws + WS_U) + ((size_t)b * SEQ + qb * 32) * D + hd * SBD;
#pragma unroll
    for (int s = 0; s < 4; ++s) { const int row = 8 * s + lrow; const v2u a = *(const LAS v2u*)(imgK + row * RS_SK + lch * 16), b2 = *(const LAS v2u*)(imgK + row * RS_SK + lch * 16 + 8);
        v4u o; o.x = a.x; o.y = a.y; o.z = b2.x; o.w = b2.y; *(v4u*)(obase + (size_t)row * D + lch * 8) = o; }
}
#define XB_TMO      128
#define XB_XCNT(j)  (256  + 64 * (j))
#define XB_XSUB(j)  (1280 + 64 * (j))
#define XB_XGEN(j)  (2304 + 64 * (j))
#define XB_TOP      3328
#define XB_TOPGEN   3392
#define XCD_BAR_WORDS 3456
#define XB_SPIN_CAP (1u << 18)

__device__ __forceinline__ unsigned xb_ld(unsigned* p)              { return __hip_atomic_load(p, __ATOMIC_RELAXED, __HIP_MEMORY_SCOPE_AGENT); }
__device__ __forceinline__ unsigned xb_add(unsigned* p, unsigned v) { return __hip_atomic_fetch_add(p, v, __ATOMIC_RELAXED, __HIP_MEMORY_SCOPE_AGENT); }
__device__ __forceinline__ unsigned xb_xcc_id() { return (unsigned)__builtin_amdgcn_s_getreg((3 << 11) | 20) & 0xFu; }
#define XB_SPIN(cond, bar) do { unsigned _sp = 0; while (cond) { __builtin_amdgcn_s_sleep(1); \
    if ((++_sp & 255u) == 0u) { if (xb_ld(&(bar)[XB_TMO])) break; if (_sp > XB_SPIN_CAP) { atomicAdd(&(bar)[XB_TMO], 1u); break; } } } } while (0)

struct XcdBarrier {
    unsigned* bar; unsigned x;
    volatile LAS unsigned* st;
};

__device__ __forceinline__ XcdBarrier xcd_barrier_post(unsigned* bar, volatile LAS unsigned* st) {
    XcdBarrier b; b.bar = bar; b.x = xb_xcc_id(); b.st = st;
    if (threadIdx.x == 0) (void)xb_add(&bar[XB_XCNT(b.x)], 1u);
    return b;
}
__device__ __forceinline__ void xcd_barrier_complete(unsigned* bar, unsigned x, unsigned& nloc, unsigned& nx) {
    const unsigned G = gridDim.x * gridDim.y * gridDim.z;
    unsigned sum, cnt, mine, sp = 0u;
    for (;;) {
        sum = 0u; cnt = 0u; mine = 0u;
#pragma unroll
        for (unsigned j = 0; j < 16; ++j) { const unsigned c = xb_ld(&bar[XB_XCNT(j)]); sum += c; cnt += (c > 0u) ? 1u : 0u; mine = (j == x) ? c : mine; }
        if (sum == G) break;
        __builtin_amdgcn_s_sleep(1);
        if ((++sp & 255u) == 0u) { if (xb_ld(&bar[XB_TMO])) break; if (sp > XB_SPIN_CAP) { atomicAdd(&bar[XB_TMO], 1u); break; } }
    }
    nloc = mine > 0u ? mine : 1u; nx = cnt > 0u ? cnt : 1u;
}

__device__ __forceinline__ void xcd_barrier(const XcdBarrier& b) {
    asm volatile("s_waitcnt vmcnt(0)" ::: "memory");
    __syncthreads();
    if (threadIdx.x == 0) {
        unsigned* bar = b.bar;
        __builtin_amdgcn_s_waitcnt(0);
        unsigned nloc = b.st[0], nx = b.st[1];
        if (nloc == 0u) { xcd_barrier_complete(bar, b.x, nloc, nx); b.st[0] = nloc; b.st[1] = nx; }
        const unsigned old = xb_add(&bar[XB_XSUB(b.x)], 1u);
        const unsigned gen = old / nloc;
        if (old + 1u == (gen + 1u) * nloc) {
            __builtin_amdgcn_fence(__ATOMIC_RELEASE, "agent");
            asm volatile("s_waitcnt vmcnt(0)" ::: "memory");
            const unsigned og = xb_add(&bar[XB_TOP], 1u);
            const unsigned tg = og / nx;
            if (og + 1u == (tg + 1u) * nx) xb_add(&bar[XB_TOPGEN], 1u);
            else XB_SPIN(xb_ld(&bar[XB_TOPGEN]) == tg, bar);
            __builtin_amdgcn_fence(__ATOMIC_ACQUIRE, "agent");
            xb_add(&bar[XB_XGEN(b.x)], 1u);
            asm volatile("s_waitcnt vmcnt(0)" ::: "memory");
        } else {
            XB_SPIN(xb_ld(&bar[XB_XGEN(b.x)]) == gen, bar);
            __builtin_amdgcn_fence(__ATOMIC_ACQUIRE, "agent");
            asm volatile("s_waitcnt vmcnt(0)" ::: "memory");
        }
    }
    __syncthreads();
}
constexpr int LDS_BYTES = 147456, MISC_OFF = 131072 + 320;
struct Args { In in; float* out; unsigned char* ws; int lo, hi; };
constexpr int NPH = 19;
__global__ void __launch_bounds__(512, 2) mk_fwd(Args a) {
    extern __shared__ __attribute__((aligned(16))) unsigned char lds_raw[];
    LAS unsigned char* lds = (LAS unsigned char*)lds_raw;
    volatile LAS unsigned* MISC = (volatile LAS unsigned*)(lds + MISC_OFF);
    const int tid = threadIdx.x, lane = tid & 63, wave = __builtin_amdgcn_readfirstlane(tid >> 6);
    unsigned char* ws = a.ws; unsigned* ctl = (unsigned*)(ws + WS_CTL);
    for (int u = tid; u < (LDS_BYTES - 131072) / 4; u += 512) ((LAS unsigned*)(lds + 131072))[u] = 0u;
    __syncthreads();
    const int lo = a.lo, hi = a.hi; const bool multi = (hi - lo) > 1;
    XcdBarrier bar; bar.bar = ctl + CW_BAR; bar.x = 0; bar.st = nullptr;
    if (multi) bar = xcd_barrier_post(ctl + CW_BAR, MISC + 8);
    const bf16* WIN = (const bf16*)(ws + WS_WIN); const bf16* WAO = (const bf16*)(ws + WS_WAO); const bf16* WQKV = (const bf16*)(ws + WS_WQKV); const bf16* WBO = (const bf16*)(ws + WS_WBO);
    bf16* PROJ = (bf16*)(ws + WS_PROJ); bf16* U = (bf16*)(ws + WS_U); bf16* H = (bf16*)(ws + WS_H);
#ifndef PROBE_ID
#define PROBE_ID -1
#endif
#define PHASE(id, ...) do { if (lo <= (id) && (id) < hi) { __VA_ARGS__ if ((id) == PROBE_ID) { __syncthreads(); __VA_ARGS__ } if ((id) + 1 < hi) xcd_barrier(bar); } } while (0)
#define GEMM_B(id, W, RF32, R) PHASE(id, { pg8::Gemm g{U, W, T, D, D}; pg8::StaticOrder S; S.init(T, D, gridDim.x, blockIdx.x); pg8::EpiResBf16<RF32> E{H, R, D}; \
            pg8::gemm_phase<pg8::EpiResBf16<RF32>, pg8::StaticOrder, true, true>(lds, g, S, E); })
#define MOE(id0, layer) do { \
        PHASE((id0), { ph_router(a.in, ws, H, layer, lds); }); \
        PHASE((id0) + 1, { ph_positions(ws, layer, (LAS int*)lds); }); \
        PHASE((id0) + 2, { LAS int* tp = (LAS int*)(lds + 131072); build_tile_prefix(ctl + CW_CNT + 64 * layer, tp); \
            pg8::Gemm g{(const bf16*)(ws + WS_H8), (const bf16*)(ws + WS_W1 + (size_t)layer * 16 * 1024 * D), XROWS, 1024, D / 2}; pg8::MoeOrder S{tp, (int)gridDim.x, (int)blockIdx.x}; pg8::EpiSwiGLU8 E{ws + WS_HDN, DE, 4}; \
            pg8::gemm_phase_gather<pg8::EpiSwiGLU8, pg8::MoeOrder, true, 124, 124>(lds, g, (const unsigned*)(ws + WS_ROWOFF), (LAS unsigned*)(lds + 131072 + 1024), S, E); }); \
        PHASE((id0) + 3, { LAS int* tp = (LAS int*)(lds + 131072); build_tile_prefix(ctl + CW_CNT + 64 * layer, tp); \
            pg8::Gemm g{(const bf16*)(ws + WS_HDN), (const bf16*)(ws + WS_W2 + (size_t)layer * 16 * 1024 * DE), XROWS, 1024, DE / 2}; pg8::MoeOrder S{tp, (int)gridDim.x, (int)blockIdx.x}; pg8::EpiScaleRows8 E{ws + WS_Y, D, 4, (const float*)(ws + WS_RS2), (const LAS float*)(lds + 131072 + 2048)}; \
            pg8::gemm_phase_gather<pg8::EpiScaleRows8, pg8::MoeOrder, true, 124, 124>(lds, g, (const unsigned*)(ws + WS_ROWID), (LAS unsigned*)(lds + 131072 + 1024), S, E); }); \
        PHASE((id0) + 4, { ph_combine(a.in, ws, a.out, layer); }); } while (0)
    PHASE(0, { LAS float* scr = (LAS float*)(lds + wave * (64 * 33 * 4));
        prologue_items(a.in, ws, scr, blockIdx.x * 8 + wave, gridDim.x * 8, lane, 0, IT_WIN);
        __syncthreads();
        ph_norm_in(a.in, ws, (LAS float*)lds); });
    PHASE(1, { const int ngw = gridDim.x * 8, kb = ((int)(blockIdx.x & 3) * 14 + 2) / 3; const int itm = IT_WIN + kb * ngw < IT_TOTAL ? IT_WIN + kb * ngw : IT_TOTAL;
            { LAS float* scr = (LAS float*)(lds + wave * (64 * 33 * 4)); prologue_items(a.in, ws, scr, blockIdx.x * 8 + wave, ngw, lane, IT_WIN, itm); }
            __syncthreads();
            { pg8::Gemm g{U, WIN, T, NPROJ, D}; pg8::StaticOrder S; S.init(T, NPROJ, gridDim.x, blockIdx.x); pg8::EpiBf16Plain E{PROJ, NPROJ, NPROJ / 256};
              pg8::gemm_phase<pg8::EpiBf16Plain, pg8::StaticOrder, true, true>(lds, g, S, E); }
            __syncthreads();
            { LAS float* scr = (LAS float*)(lds + wave * (64 * 33 * 4)); prologue_items(a.in, ws, scr, blockIdx.x * 8 + wave, ngw, lane, itm, IT_TOTAL); } });
    PHASE(2, { for (int u = blockIdx.x; u < BATCH * GH * (NCH / 4); u += gridDim.x) gla_g1_super(a.in, ws, lds, u); });
    PHASE(3, { gla_g2_super(ws, (LAS float*)lds); });
    PHASE(4, { for (int u = blockIdx.x; u < BATCH * GH * (NCH / 4); u += gridDim.x) gla_g3_super(a.in, ws, lds, u); });
    GEMM_B(5, WAO, true, (const void*)a.in.x);
    MOE(6, 0);
    PHASE(11, { pg8::Gemm g{H, WQKV, T, NPROJ, D}; pg8::StaticOrder S; S.init(T, NPROJ, gridDim.x, blockIdx.x); pg8::EpiScaleRows E{PROJ, NPROJ, NPROJ / 256, (const float*)(ws + WS_RSTD), (const LAS float*)(lds + 131072 + 2048)};
            pg8::gemm_phase<pg8::EpiScaleRows, pg8::StaticOrder, true, true>(lds, g, S, E); });
    PHASE(12, { for (int task = blockIdx.x * 8 + wave; task < BATCH * SBH * (SEQ / 32); task += gridDim.x * 8) sb_attn_task(ws, lds + wave * SB_WAVE_LDS, task, lane); });
    GEMM_B(13, WBO, false, (const void*)H);
    MOE(14, 1);
}
#ifndef MK_PER_PHASE
#define MK_PER_PHASE 0
#endif
extern "C" void kernel_launch(void* const* d_in, const int* in_sizes, int n_in, void* d_out, int out_size, void* d_ws, size_t ws_size, hipStream_t stream) {
    static int grid = 0;
    if (grid == 0) {
        if (n_in != 21 || in_sizes[0] != T * D || out_size != T * D || ws_size < WS_END) { fprintf(stderr, "kernel_launch: unexpected shapes (n_in %d, in0 %d, out %d, ws %zu); nothing launched\n", n_in, n_in > 0 ? in_sizes[0] : -1, out_size, ws_size); grid = -1; return; }
        int dev = 0, cus = 0, per_cu = 0;
        if (hipGetDevice(&dev) != hipSuccess || hipDeviceGetAttribute(&cus, hipDeviceAttributeMultiprocessorCount, dev) != hipSuccess) { grid = -1; return; }
        if (hipFuncSetAttribute((const void*)mk_fwd, hipFuncAttributeMaxDynamicSharedMemorySize, LDS_BYTES) != hipSuccess) { fprintf(stderr, "kernel_launch: hipFuncSetAttribute failed\n"); grid = -1; return; }
        if (hipOccupancyMaxActiveBlocksPerMultiprocessor(&per_cu, (const void*)mk_fwd, 512, LDS_BYTES) != hipSuccess || per_cu < 1) { fprintf(stderr, "kernel_launch: occupancy query says %d\n", per_cu); (void)hipGetLastError(); grid = -1; return; }
        if (cus < 256) { fprintf(stderr, "kernel_launch: this kernel needs 256 CUs (one resident workgroup each); device has %d\n", cus); grid = -1; return; }
        grid = 256;
    }
    if (grid < 0) return;
    (void)hipMemsetAsync((unsigned char*)d_ws + WS_CTL, 0, CTL_ZERO_BYTES, stream);
    Args a{}; { const float** p = (const float**)&a.in; for (int i = 0; i < 21; ++i) p[i] = (const float*)d_in[i]; }
    a.out = (float*)d_out; a.ws = (unsigned char*)d_ws;
#if MK_PER_PHASE
    for (int p = 0; p < NPH; ++p) { a.lo = p; a.hi = p + 1; hipLaunchKernelGGL(mk_fwd, dim3(grid), dim3(512), LDS_BYTES, stream, a); }
#else
    a.lo = 0; a.hi = NPH; hipLaunchKernelGGL(mk_fwd, dim3(grid), dim3(512), LDS_BYTES, stream, a);
#endif
}
```

```cpp
#include <hip/hip_runtime.h>
#include <cstdio>
#include <cstdint>
__device__ __forceinline__ int tidx_opaque() { int t = (int)threadIdx.x; asm volatile("" : "+v"(t)); return t; }
#define TIDX tidx_opaque()
namespace pg8 {
#define PG8_LAS __attribute__((address_space(3)))
typedef unsigned short bf16_t;
typedef short bf16x8 __attribute__((ext_vector_type(8)));
typedef float f32x4 __attribute__((ext_vector_type(4)));
typedef unsigned u32x4 __attribute__((ext_vector_type(4)));
constexpr int BM = 256, BK = 64, HALF = 128, HTB = HALF * BK * 2  , STAGE_BYTES = 8 * HTB, NXCD = 8, WGM = 8;

__host__ __device__ __forceinline__ int lds_byte(int r, int c) { const int st = (r >> 4) * 2 + (c >> 5), rr = r & 15, cc = c & 31, ob = rr * 64 + cc * 2; return st * 1024 + (ob ^ (((ob >> 9) & 1) << 5)); }
__host__ __device__ __forceinline__ void stage_rc(int b, int& R, int& C) { const int st = b / 1024, sb = b % 1024, swz = sb ^ (((sb >> 9) & 1) << 5); R = (st >> 1) * 16 + swz / 64; C = (st & 1) * 32 + (swz % 64) / 2; }
__host__ __device__ __forceinline__ int perm32(int rho) { const int n = rho >> 4, i = rho & 15; return 8 * (i >> 2) + 4 * n + (i & 3); }

struct Unit { int pm, pn; };
struct Gemm { const bf16_t* A; const bf16_t* Bt; int M, N, K; };

struct StaticOrder {
    int nM, nN, nwg, G, c;
    __host__ __device__ void init(int M, int N, int G_, int c_) { nM = M / BM; nN = N / BM; nwg = nM * nN; G = G_; c = c_; }
    __host__ __device__ bool next(int i, Unit& u) const {
        const long L = (long)i * G + c; if (L >= nwg) return false;
        int wgid = (int)L; { const int q = nwg / NXCD, r = nwg % NXCD, xcd = wgid % NXCD, off = wgid / NXCD; wgid = (xcd < r ? xcd * (q + 1) : r * (q + 1) + (xcd - r) * q) + off; }
        const int nig = WGM * nN, gid = wgid / nig, fm = gid * WGM, gsz = (nM - fm) < WGM ? (nM - fm) : WGM;
        u.pm = fm + ((wgid % nig) % gsz); u.pn = (wgid % nig) / gsz; return true;
    }
    __device__ __forceinline__ void a_ready(const Unit&) const {}
    __device__ __forceinline__ void done(const Unit&) const {}
};
struct RangeOrder {
    StaticOrder S; int off, n;
    __device__ __forceinline__ bool next(int i, Unit& u) const { return i < n && S.next(off + i, u); }
    __device__ __forceinline__ void a_ready(const Unit&) const {}
    __device__ __forceinline__ void done(const Unit&) const {}
};

typedef int v4i_t __attribute__((ext_vector_type(4)));
typedef int v8i_t __attribute__((ext_vector_type(8)));
__device__ __forceinline__ v8i_t cat8(bf16x8 a, bf16x8 b) { const v4i_t x = __builtin_bit_cast(v4i_t, a), y = __builtin_bit_cast(v4i_t, b); return __builtin_shufflevector(x, y, 0, 1, 2, 3, 4, 5, 6, 7); }
__device__ __forceinline__ float clamp8(float x) { return fminf(fmaxf(x, -448.f), 448.f); }
__device__ __forceinline__ unsigned pk_fp8x4(float a, float b, float c, float d) { int p = __builtin_amdgcn_cvt_pk_fp8_f32(clamp8(a), clamp8(b), 0, false); p = __builtin_amdgcn_cvt_pk_fp8_f32(clamp8(c), clamp8(d), p, true); return (unsigned)p; }
__device__ __forceinline__ unsigned pk_fp8x4_nc(float a, float b, float c, float d) { int p = __builtin_amdgcn_cvt_pk_fp8_f32(a, b, 0, false); p = __builtin_amdgcn_cvt_pk_fp8_f32(c, d, p, true); return (unsigned)p; }
__device__ __forceinline__ unsigned cvt_pk_bf16(float lo, float hi) { unsigned r; asm volatile("v_cvt_pk_bf16_f32 %0, %1, %2" : "=v"(r) : "v"(lo), "v"(hi)); return r; }
struct EpiBf16Plain {
    static constexpr bool PERM = true, AFTER_DRAIN = false, ROWSCALE = false;
    bf16_t* O; int ldc; int nct;
    __device__ __forceinline__ void operator()(const f32x4 (&acc)[2][2][4][2], const Unit& u, int wr, int wc, int fr, int fq) const {
        const int row0 = u.pm * BM + wr * 64 + fr; const int col0 = (u.pn % nct) * BM + wc * 32 + 8 * fq;
#pragma unroll
        for (int ai = 0; ai < 2; ++ai)
#pragma unroll
            for (int m = 0; m < 4; ++m) { bf16_t* rowp = O + (size_t)(row0 + ai * HALF + m * 16) * ldc + col0;
#pragma unroll
                for (int bj = 0; bj < 2; ++bj) { const f32x4 v0 = acc[ai][bj][m][0], v1 = acc[ai][bj][m][1];
                    u32x4 w; w.x = cvt_pk_bf16(v0[0], v0[1]); w.y = cvt_pk_bf16(v0[2], v0[3]); w.z = cvt_pk_bf16(v1[0], v1[1]); w.w = cvt_pk_bf16(v1[2], v1[3]);
                    *(u32x4*)(rowp + bj * HALF) = w; } }
    }
};
struct EpiScaleRows {
    static constexpr bool PERM = true, AFTER_DRAIN = false, ROWSCALE = true;
    bf16_t* O; int ldc; int nct; const float* rs; const PG8_LAS float* rsl;
    __device__ __forceinline__ void operator()(const f32x4 (&acc)[2][2][4][2], const Unit& u, int wr, int wc, int fr, int fq) const {
        const int row0 = u.pm * BM + wr * 64 + fr; const int col0 = (u.pn % nct) * BM + wc * 32 + 8 * fq;
#pragma unroll
        for (int ai = 0; ai < 2; ++ai)
#pragma unroll
            for (int m = 0; m < 4; ++m) { const int row = row0 + ai * HALF + m * 16; const float s = rsl[wr * 64 + fr + ai * HALF + m * 16]; bf16_t* rowp = O + (size_t)row * ldc + col0;
#pragma unroll
                for (int bj = 0; bj < 2; ++bj) { const f32x4 v0 = acc[ai][bj][m][0] * s, v1 = acc[ai][bj][m][1] * s;
                    u32x4 w; w.x = cvt_pk_bf16(v0[0], v0[1]); w.y = cvt_pk_bf16(v0[2], v0[3]); w.z = cvt_pk_bf16(v1[0], v1[1]); w.w = cvt_pk_bf16(v1[2], v1[3]);
                    *(u32x4*)(rowp + bj * HALF) = w; } }
    }
};
struct EpiScaleRows8 {
    static constexpr bool PERM = true, AFTER_DRAIN = false, ROWSCALE = true;
    unsigned char* O; int ldc; int nct; const float* rs; const PG8_LAS float* rsl;
    __device__ __forceinline__ void operator()(const f32x4 (&acc)[2][2][4][2], const Unit& u, int wr, int wc, int fr, int fq) const {
        const int row0 = u.pm * BM + wr * 64 + fr; const int col0 = (u.pn % nct) * BM + wc * 32 + 8 * fq;
        typedef unsigned u32x2 __attribute__((ext_vector_type(2)));
#pragma unroll
        for (int ai = 0; ai < 2; ++ai)
#pragma unroll
            for (int m = 0; m < 4; ++m) { const int row = row0 + ai * HALF + m * 16; const float s = rsl[wr * 64 + fr + ai * HALF + m * 16] * 16.f; unsigned char* rowp = O + (size_t)row * ldc + col0;
#pragma unroll
                for (int bj = 0; bj < 2; ++bj) { const f32x4 v0 = acc[ai][bj][m][0] * s, v1 = acc[ai][bj][m][1] * s;
                    u32x2 w; w.x = pk_fp8x4(v0[0], v0[1], v0[2], v0[3]); w.y = pk_fp8x4(v1[0], v1[1], v1[2], v1[3]);
                    *(u32x2*)(rowp + bj * HALF) = w; } }
    }
};
__device__ __forceinline__ float silu_f(float g) { return g * __builtin_amdgcn_rcpf(1.f + __expf(-g)); }
struct EpiSwiGLU {
    static constexpr bool PERM = true, AFTER_DRAIN = false, ROWSCALE = false;
    bf16_t* O; int ldc; int nct;
    __device__ __forceinline__ void operator()(const f32x4 (&acc)[2][2][4][2], const Unit& u, int wr, int wc, int fr, int fq) const {
        const int row0 = u.pm * BM + wr * 64 + fr; const int col0 = (u.pn % nct) * HALF + wc * 32 + 8 * fq;
#pragma unroll
        for (int ai = 0; ai < 2; ++ai)
#pragma unroll
            for (int m = 0; m < 4; ++m) { bf16_t* rowp = O + (size_t)(row0 + ai * HALF + m * 16) * ldc + col0;
                const f32x4 g0 = acc[ai][0][m][0], g1 = acc[ai][0][m][1], u0 = acc[ai][1][m][0], u1 = acc[ai][1][m][1];
                u32x4 w; w.x = cvt_pk_bf16(silu_f(g0[0]) * u0[0], silu_f(g0[1]) * u0[1]); w.y = cvt_pk_bf16(silu_f(g0[2]) * u0[2], silu_f(g0[3]) * u0[3]);
                w.z = cvt_pk_bf16(silu_f(g1[0]) * u1[0], silu_f(g1[1]) * u1[1]); w.w = cvt_pk_bf16(silu_f(g1[2]) * u1[2], silu_f(g1[3]) * u1[3]);
                *(u32x4*)rowp = w; }
    }
};
typedef float f32x2e __attribute__((ext_vector_type(2)));
__device__ __forceinline__ f32x2e swiglu8_2(f32x2e g, f32x2e u) {
    const f32x2e ng = g * -1.4426950408889634f; f32x2e e; e.x = __builtin_amdgcn_exp2f(ng.x); e.y = __builtin_amdgcn_exp2f(ng.y);
    const f32x2e d = e * 0.125f + 0.125f; f32x2e r; r.x = __builtin_amdgcn_rcpf(d.x); r.y = __builtin_amdgcn_rcpf(d.y);
    return (g * u) * r;
}
struct EpiSwiGLU8 {
    static constexpr bool PERM = true, AFTER_DRAIN = false, ROWSCALE = false;
    unsigned char* O; int ldc; int nct;
    __device__ __forceinline__ void operator()(const f32x4 (&acc)[2][2][4][2], const Unit& u, int wr, int wc, int fr, int fq) const {
        const int row0 = u.pm * BM + wr * 64 + fr; const int col0 = (u.pn % nct) * HALF + wc * 32 + 8 * fq;
#pragma unroll
        for (int ai = 0; ai < 2; ++ai)
#pragma unroll
            for (int m = 0; m < 4; ++m) { unsigned char* rowp = O + (size_t)(row0 + ai * HALF + m * 16) * ldc + col0;
                const f32x4 g0 = acc[ai][0][m][0], g1 = acc[ai][0][m][1], u0 = acc[ai][1][m][0], u1 = acc[ai][1][m][1];
                typedef unsigned u32x2 __attribute__((ext_vector_type(2))); u32x2 w;
                const f32x2e a0 = swiglu8_2((f32x2e){g0[0], g0[1]}, (f32x2e){u0[0], u0[1]}), a1 = swiglu8_2((f32x2e){g0[2], g0[3]}, (f32x2e){u0[2], u0[3]}), a2 = swiglu8_2((f32x2e){g1[0], g1[1]}, (f32x2e){u1[0], u1[1]}), a3 = swiglu8_2((f32x2e){g1[2], g1[3]}, (f32x2e){u1[2], u1[3]});
                w.x = pk_fp8x4(a0.x, a0.y, a1.x, a1.y);
                w.y = pk_fp8x4(a2.x, a2.y, a3.x, a3.y);
                *(u32x2*)rowp = w; }
    }
};
struct EpiSwiGLUScaled {
    static constexpr bool PERM = true, AFTER_DRAIN = false, ROWSCALE = true;
    bf16_t* O; int ldc; int nct; const float* rs; const PG8_LAS float* rsl;
    __device__ __forceinline__ void operator()(const f32x4 (&acc)[2][2][4][2], const Unit& u, int wr, int wc, int fr, int fq) const {
        const int row0 = u.pm * BM + wr * 64 + fr; const int col0 = (u.pn % nct) * HALF + wc * 32 + 8 * fq;
#pragma unroll
        for (int ai = 0; ai < 2; ++ai)
#pragma unroll
            for (int m = 0; m < 4; ++m) { const int row = row0 + ai * HALF + m * 16; const float s = rsl[wr * 64 + fr + ai * HALF + m * 16]; bf16_t* rowp = O + (size_t)row * ldc + col0;
                const f32x4 g0 = acc[ai][0][m][0] * s, g1 = acc[ai][0][m][1] * s, u0 = acc[ai][1][m][0] * s, u1 = acc[ai][1][m][1] * s;
                u32x4 w; w.x = cvt_pk_bf16(silu_f(g0[0]) * u0[0], silu_f(g0[1]) * u0[1]); w.y = cvt_pk_bf16(silu_f(g0[2]) * u0[2], silu_f(g0[3]) * u0[3]);
                w.z = cvt_pk_bf16(silu_f(g1[0]) * u1[0], silu_f(g1[1]) * u1[1]); w.w = cvt_pk_bf16(silu_f(g1[2]) * u1[2], silu_f(g1[3]) * u1[3]);
                *(u32x4*)rowp = w; }
    }
};
template <bool RF32> struct EpiResBf16 {
    static constexpr bool PERM = true, AFTER_DRAIN = false, ROWSCALE = false;
    bf16_t* O; const void* R; int ldc;
    __device__ __forceinline__ void operator()(const f32x4 (&acc)[2][2][4][2], const Unit& u, int wr, int wc, int fr, int fq) const {
        const int row0 = u.pm * BM + wr * 64 + fr; const int col0 = u.pn * BM + wc * 32 + 8 * fq;
        if constexpr (RF32) {
#pragma unroll
            for (int ai = 0; ai < 2; ++ai) { f32x4 r0[4][2], r1[4][2];
#pragma unroll
                for (int m = 0; m < 4; ++m)
#pragma unroll
                    for (int bj = 0; bj < 2; ++bj) { const size_t ro = (size_t)(row0 + ai * HALF + m * 16) * ldc + col0 + bj * HALF; r0[m][bj] = *(const f32x4*)((const float*)R + ro); r1[m][bj] = *(const f32x4*)((const float*)R + ro + 4); }
#pragma unroll
                for (int m = 0; m < 4; ++m)
#pragma unroll
                    for (int bj = 0; bj < 2; ++bj) { const size_t ro = (size_t)(row0 + ai * HALF + m * 16) * ldc + col0 + bj * HALF; const f32x4 v0 = acc[ai][bj][m][0] + r0[m][bj], v1 = acc[ai][bj][m][1] + r1[m][bj];
                        u32x4 w; w.x = cvt_pk_bf16(v0[0], v0[1]); w.y = cvt_pk_bf16(v0[2], v0[3]); w.z = cvt_pk_bf16(v1[0], v1[1]); w.w = cvt_pk_bf16(v1[2], v1[3]);
                        *(u32x4*)(O + ro) = w; } }
        } else {
            u32x4 rr[2][4][2];
#pragma unroll
            for (int ai = 0; ai < 2; ++ai)
#pragma unroll
                for (int m = 0; m < 4; ++m)
#pragma unroll
                    for (int bj = 0; bj < 2; ++bj) rr[ai][m][bj] = *(const u32x4*)((const bf16_t*)R + (size_t)(row0 + ai * HALF + m * 16) * ldc + col0 + bj * HALF);
#pragma unroll
            for (int ai = 0; ai < 2; ++ai)
#pragma unroll
                for (int m = 0; m < 4; ++m)
#pragma unroll
                    for (int bj = 0; bj < 2; ++bj) { const size_t ro = (size_t)(row0 + ai * HALF + m * 16) * ldc + col0 + bj * HALF; f32x4 v0 = acc[ai][bj][m][0], v1 = acc[ai][bj][m][1]; const u32x4 q = rr[ai][m][bj];
                        v0[0] += __builtin_bit_cast(float, q.x << 16); v0[1] += __builtin_bit_cast(float, q.x & 0xffff0000u); v0[2] += __builtin_bit_cast(float, q.y << 16); v0[3] += __builtin_bit_cast(float, q.y & 0xffff0000u);
                        v1[0] += __builtin_bit_cast(float, q.z << 16); v1[1] += __builtin_bit_cast(float, q.z & 0xffff0000u); v1[2] += __builtin_bit_cast(float, q.w << 16); v1[3] += __builtin_bit_cast(float, q.w & 0xffff0000u);
                        u32x4 w; w.x = cvt_pk_bf16(v0[0], v0[1]); w.y = cvt_pk_bf16(v0[2], v0[3]); w.z = cvt_pk_bf16(v1[0], v1[1]); w.w = cvt_pk_bf16(v1[2], v1[3]);
                        *(u32x4*)(O + ro) = w; }
        }
    }
};
struct MoeOrder {
    const PG8_LAS int* tp; int G, c;
    __device__ __forceinline__ bool next(int i, Unit& u) const {
        const int ntot = tp[16] * 4; const long L = (long)i * G + c; if (L >= ntot) return false;
        int wgid = (int)L; { const int q = ntot / NXCD, r = ntot % NXCD, xcd = wgid % NXCD, off = wgid / NXCD; wgid = (xcd < r ? xcd * (q + 1) : r * (q + 1) + (xcd - r) * q) + off; }
        const int rt = wgid >> 2, pnl = wgid & 3; int e = 0;
#pragma unroll
        for (int j = 1; j < 16; ++j) e += (rt >= tp[j]) ? 1 : 0;
        u.pm = rt; u.pn = __builtin_amdgcn_readfirstlane(e * 4 + pnl); return true;
    }
    __device__ __forceinline__ void a_ready(const Unit&) const {}
    __device__ __forceinline__ void done(const Unit&) const {}
};
template <class Epi, class Sched, bool ALIGN_EPI = false, bool SP2 = false, bool FP8 = false, int SCW = 127, int SCA = 127>
__device__ __forceinline__ void gemm_phase(PG8_LAS unsigned char* lds, const Gemm g, const Sched& S, const Epi& E) {
    const int tid = TIDX, wid = __builtin_amdgcn_readfirstlane(tid >> 6), lane = tid & 63, wr = wid >> 2, wc = wid & 3, fr = lane & 15, fq = lane >> 4;
    const int K = g.K; int nt = K / BK; if constexpr (FP8) asm volatile("" : "+s"(nt));
    unsigned voffA[2], voffB[2];
#pragma unroll
    for (int i = 0; i < 2; ++i) { int R, C; stage_rc(tid * 16 + i * 8192, R, C); const int Rb = Epi::PERM ? ((R & ~31) + perm32(R & 31)) : R;
        voffA[i] = (unsigned)(R * K + C) * 2u; voffB[i] = (unsigned)(Rb * K + C) * 2u; }
    const size_t kstep = (size_t)(BK * 2);
    const size_t hstep = (size_t)HALF * K * 2;
    const size_t tstep = 2 * hstep;
    const unsigned ldsw = (unsigned)wid * 1024u;
    int aoff = lds_byte(wr * 64 + fr, fq * 8), boff = lds_byte(wc * 32 + fr, fq * 8);
#define PG8_SA(b, h) (((b) * 2 + (h)) * HTB)
#define PG8_SB(b, h) ((4 + (b) * 2 + (h)) * HTB)
#define PG8_UNI(p) (FP8 ? (const char*)(((unsigned long long)(unsigned)__builtin_amdgcn_readfirstlane((int)((unsigned long long)(p) >> 32)) << 32) | (unsigned long long)(unsigned)__builtin_amdgcn_readfirstlane((int)(unsigned long long)(p))) : (const char*)(p))
#define PG8_STAGE(bufoff, gbase, voff) do { const char* _gb = PG8_UNI(gbase); _Pragma("unroll") for (int _i = 0; _i < 2; ++_i) \
        __builtin_amdgcn_global_load_lds((const unsigned*)(_gb + (voff)[_i]), (PG8_LAS unsigned*)(lds + (bufoff) + ldsw + _i * 8192), 16, 0, 0); } while (0)
#define PG8_LDA(dst, b, h) do { _Pragma("unroll") for (int m = 0; m < 4; ++m) { const bf16x8 _l0 = *(const PG8_LAS bf16x8*)(lds + PG8_SA(b, h) + aoff + m * 2048), _l1 = *(const PG8_LAS bf16x8*)(lds + PG8_SA(b, h) + aoff + m * 2048 + 1024); \
        if constexpr (FP8) dst##8[m] = cat8(_l0, _l1); else { dst[m][0] = _l0; dst[m][1] = _l1; } } } while (0)
#define PG8_LDB(dst, b, h) do { _Pragma("unroll") for (int n = 0; n < 2; ++n) { const bf16x8 _l0 = *(const PG8_LAS bf16x8*)(lds + PG8_SB(b, h) + boff + n * 2048), _l1 = *(const PG8_LAS bf16x8*)(lds + PG8_SB(b, h) + boff + n * 2048 + 1024); \
        if constexpr (FP8) dst##8[n] = cat8(_l0, _l1); else { dst[n][0] = _l0; dst[n][1] = _l1; } } } while (0)
#define PG8_MMA(ai, bj, At, Bt) do { __builtin_amdgcn_s_setprio(1); _Pragma("unroll") for (int m = 0; m < 4; ++m) _Pragma("unroll") for (int n = 0; n < 2; ++n) { \
        if constexpr (FP8) acc[ai][bj][m][n] = __builtin_amdgcn_mfma_scale_f32_16x16x128_f8f6f4(Bt##8[n], At##8[m], acc[ai][bj][m][n], 0, 0, 0, SCW, 0, SCA); \
        else { _Pragma("unroll") for (int k = 0; k < 2; ++k) acc[ai][bj][m][n] = __builtin_amdgcn_mfma_f32_16x16x32_bf16(Bt[n][k], At[m][k], acc[ai][bj][m][n], 0, 0, 0); } } \
        if constexpr (FP8) asm volatile("" : "+v"(acc[ai][bj][0][0]), "+v"(acc[ai][bj][0][1]), "+v"(acc[ai][bj][1][0]), "+v"(acc[ai][bj][1][1]), "+v"(acc[ai][bj][2][0]), "+v"(acc[ai][bj][2][1]), "+v"(acc[ai][bj][3][0]), "+v"(acc[ai][bj][3][1]));   \
        __builtin_amdgcn_s_setprio(0); } while (0)
#define PG8_WAIT_V(n) asm volatile("s_waitcnt vmcnt(" #n ")" ::: "memory")
#define PG8_WAIT_L(n) asm volatile("s_waitcnt lgkmcnt(" #n ")" ::: "memory")
#define PG8_BAR __builtin_amdgcn_s_barrier()
#define PG8_SCHED __builtin_amdgcn_sched_barrier(0)
    Unit cur, nxt; int ui = 0;
    if (!S.next(0, cur)) return;
    f32x4 acc[2][2][4][2];
#pragma unroll
    for (int a = 0; a < 2; ++a)
#pragma unroll
        for (int b = 0; b < 2; ++b)
#pragma unroll
            for (int m = 0; m < 4; ++m)
#pragma unroll
                for (int n = 0; n < 2; ++n) acc[a][b][m][n] = (f32x4){0.f, 0.f, 0.f, 0.f};
    bf16x8 At[4][2], B0[2][2], B1[2][2]; v8i_t At8[4], B08[2], B18[2];
    const char* cA = (const char*)g.A + (size_t)cur.pm * tstep; const char* cB = (const char*)g.Bt + (size_t)cur.pn * tstep;
    S.a_ready(cur);
    if constexpr (SP2) {
        PG8_STAGE(PG8_SB(0, 0), cB, voffB); PG8_STAGE(PG8_SB(0, 1), cB + hstep, voffB); PG8_STAGE(PG8_SA(0, 0), cA, voffA); PG8_STAGE(PG8_SA(0, 1), cA + hstep, voffA);
        if (wr == 1) PG8_BAR;
        PG8_WAIT_V(2); PG8_BAR;
        PG8_STAGE(PG8_SB(1, 0), cB + kstep, voffB); PG8_STAGE(PG8_SA(1, 0), cA + kstep, voffA); PG8_STAGE(PG8_SB(1, 1), cB + hstep + kstep, voffB);
        PG8_WAIT_V(6); PG8_BAR;
    } else {
        PG8_STAGE(PG8_SB(0, 0), cB, voffB); PG8_STAGE(PG8_SA(0, 0), cA, voffA); PG8_STAGE(PG8_SB(0, 1), cB + hstep, voffB); PG8_STAGE(PG8_SA(0, 1), cA + hstep, voffA);
        if (wr == 1) PG8_BAR;
        PG8_WAIT_V(4); PG8_BAR;
        PG8_STAGE(PG8_SB(1, 0), cB + kstep, voffB); PG8_STAGE(PG8_SA(1, 0), cA + kstep, voffA); PG8_STAGE(PG8_SB(1, 1), cB + hstep + kstep, voffB);
        PG8_WAIT_V(6); PG8_BAR;
    }
    for (;;) {
        const bool has_next = S.next(ui + 1, nxt);
        if constexpr (Epi::ROWSCALE) { if (wid >= 4) __builtin_amdgcn_global_load_lds((const unsigned*)(E.rs + cur.pm * BM + (wid - 4) * 64 + lane), (PG8_LAS unsigned*)(E.rsl + (wid - 4) * 64), 4, 0, 0); }
        const char* nA = has_next ? (const char*)g.A + (size_t)nxt.pm * tstep : cA; const char* nB = has_next ? (const char*)g.Bt + (size_t)nxt.pn * tstep : cB;
        for (int t = 0; t < nt; t += 2) {
            const bool last = (t == nt - 2);
            if constexpr (FP8) {
                int t_ = tid; asm volatile("" : "+v"(t_));
#pragma unroll
                for (int i = 0; i < 2; ++i) { int R, C; stage_rc(t_ * 16 + i * 8192, R, C); const int Rb = Epi::PERM ? ((R & ~31) + perm32(R & 31)) : R;
                    voffA[i] = (unsigned)(R * K + C) * 2u; voffB[i] = (unsigned)(Rb * K + C) * 2u; }
                const int fr_ = t_ & 15, fq_ = (t_ & 63) >> 4; aoff = lds_byte(wr * 64 + fr_, fq_ * 8); boff = lds_byte(wc * 32 + fr_, fq_ * 8); }
            const char* a1 = cA + (size_t)(t + 1) * kstep;
            const char* a2 = last ? nA : cA + (size_t)(t + 2) * kstep; const char* b2 = last ? nB : cB + (size_t)(t + 2) * kstep;
            const char* a3 = a2 + kstep; const char* b3 = b2 + kstep;
            if (last && has_next) S.a_ready(nxt);
            if constexpr (SP2) {
            PG8_LDB(B0, 0, 0); PG8_LDB(B1, 0, 1); PG8_SCHED; PG8_LDA(At, 0, 0); PG8_STAGE(PG8_SA(1, 1), a1 + hstep, voffA);
            PG8_WAIT_V(8); PG8_WAIT_L(0); PG8_BAR; PG8_MMA(0, 0, At, B0); PG8_MMA(0, 1, At, B1); PG8_BAR; PG8_SCHED;
            PG8_LDA(At, 0, 1); PG8_STAGE(PG8_SB(0, 0), b2, voffB); PG8_STAGE(PG8_SB(0, 1), b2 + hstep, voffB); PG8_STAGE(PG8_SA(0, 0), a2, voffA);
            PG8_WAIT_V(8); PG8_WAIT_L(0); PG8_BAR; PG8_MMA(1, 0, At, B0); PG8_MMA(1, 1, At, B1); PG8_BAR; PG8_SCHED;
            PG8_LDB(B0, 1, 0); PG8_LDB(B1, 1, 1); PG8_SCHED; PG8_LDA(At, 1, 0); PG8_STAGE(PG8_SA(0, 1), a2 + hstep, voffA);
            PG8_WAIT_V(8); PG8_WAIT_L(0); PG8_BAR; PG8_MMA(0, 0, At, B0); PG8_MMA(0, 1, At, B1); PG8_BAR; PG8_SCHED;
            PG8_LDA(At, 1, 1); PG8_STAGE(PG8_SB(1, 0), b3, voffB); PG8_STAGE(PG8_SB(1, 1), b3 + hstep, voffB); PG8_STAGE(PG8_SA(1, 0), a3, voffA);
            PG8_WAIT_V(8); PG8_WAIT_L(0); PG8_BAR; PG8_MMA(1, 0, At, B0); PG8_MMA(1, 1, At, B1); PG8_BAR; PG8_SCHED;
            } else {
            PG8_LDB(B0, 0, 0); PG8_SCHED; PG8_LDA(At, 0, 0); PG8_STAGE(PG8_SA(1, 1), a1 + hstep, voffA);
            PG8_WAIT_L(8); PG8_BAR; PG8_WAIT_L(0); PG8_MMA(0, 0, At, B0); PG8_BAR; PG8_SCHED;
            PG8_LDB(B1, 0, 1); PG8_STAGE(PG8_SB(0, 0), b2, voffB);
            PG8_BAR; PG8_WAIT_L(0); PG8_MMA(0, 1, At, B1); PG8_BAR;
            PG8_LDA(At, 0, 1); PG8_STAGE(PG8_SA(0, 0), a2, voffA);
            PG8_BAR; PG8_WAIT_L(0); PG8_MMA(1, 0, At, B0); PG8_BAR; PG8_SCHED;
            PG8_STAGE(PG8_SB(0, 1), b2 + hstep, voffB);
            PG8_WAIT_V(6); PG8_BAR; PG8_MMA(1, 1, At, B1); PG8_BAR;
            PG8_LDB(B0, 1, 0); PG8_SCHED; PG8_LDA(At, 1, 0); PG8_STAGE(PG8_SA(0, 1), a2 + hstep, voffA);
            PG8_WAIT_L(8); PG8_BAR; PG8_WAIT_L(0); PG8_MMA(0, 0, At, B0); PG8_BAR; PG8_SCHED;
            PG8_LDB(B1, 1, 1); PG8_STAGE(PG8_SB(1, 0), b3, voffB);
            PG8_BAR; PG8_WAIT_L(0); PG8_MMA(0, 1, At, B1); PG8_BAR;
            PG8_LDA(At, 1, 1); PG8_STAGE(PG8_SA(1, 0), a3, voffA);
            PG8_BAR; PG8_WAIT_L(0); PG8_MMA(1, 0, At, B0); PG8_BAR; PG8_SCHED;
            PG8_STAGE(PG8_SB(1, 1), b3 + hstep, voffB);
            PG8_WAIT_V(6); PG8_BAR; PG8_MMA(1, 1, At, B1); PG8_BAR;
            }
        }
        if constexpr (ALIGN_EPI) { if (wr == 0) PG8_BAR; }
        if constexpr (!Epi::AFTER_DRAIN) { E(acc, cur, wr, wc, fr, fq); S.done(cur); }
        if (!has_next) break;
#pragma unroll
        for (int a = 0; a < 2; ++a)
#pragma unroll
            for (int b = 0; b < 2; ++b)
#pragma unroll
                for (int m = 0; m < 4; ++m)
#pragma unroll
                    for (int n = 0; n < 2; ++n) acc[a][b][m][n] = (f32x4){0.f, 0.f, 0.f, 0.f};
        cur = nxt; cA = nA; cB = nB; ++ui;
        if constexpr (ALIGN_EPI) { if (wr == 1) PG8_BAR; }
    }
    PG8_WAIT_V(0);
    if constexpr (!ALIGN_EPI) { if (wr == 0) PG8_BAR; }
    PG8_BAR;
    if constexpr (Epi::AFTER_DRAIN) { E.fused(acc, cur, wr, wc, fr, fq, lds, wid, lane); S.done(cur); }
#undef PG8_SA
#undef PG8_SB
#undef PG8_STAGE
#undef PG8_UNI
#undef PG8_LDA
#undef PG8_LDB
#undef PG8_MMA
#undef PG8_WAIT_V
#undef PG8_WAIT_L
#undef PG8_BAR
#undef PG8_SCHED
}

template <class Epi, class Sched, bool FP8 = false, int SCW = 127, int SCA = 127>
__device__ __forceinline__ void gemm_phase_gather(PG8_LAS unsigned char* lds, const Gemm g, const unsigned* rowoff, PG8_LAS unsigned* tab, const Sched& S, const Epi& E) {
    constexpr bool ALIGN_EPI = true, SP2 = true;
    const int tid = TIDX, wid = __builtin_amdgcn_readfirstlane(tid >> 6), lane = tid & 63, wr = wid >> 2, wc = wid & 3, fr = lane & 15, fq = lane >> 4;
    const int K = g.K; int nt = K / BK; if constexpr (FP8) asm volatile("" : "+s"(nt));
    unsigned voffA[2], voffB[2], colA[2]; int rowA[2];
#pragma unroll
    for (int i = 0; i < 2; ++i) { int R, C; stage_rc(tid * 16 + i * 8192, R, C); const int Rb = Epi::PERM ? ((R & ~31) + perm32(R & 31)) : R;
        voffA[i] = (unsigned)(R * K + C) * 2u; voffB[i] = (unsigned)(Rb * K + C) * 2u; rowA[i] = R; colA[i] = (unsigned)C * 2u; }
    const size_t kstep = (size_t)(BK * 2);
    const size_t hstep = (size_t)HALF * K * 2;
    const size_t tstep = 2 * hstep;
    const unsigned ldsw = (unsigned)wid * 1024u;
    int aoff = lds_byte(wr * 64 + fr, fq * 8), boff = lds_byte(wc * 32 + fr, fq * 8);
#define PG8_SA(b, h) (((b) * 2 + (h)) * HTB)
#define PG8_SB(b, h) ((4 + (b) * 2 + (h)) * HTB)
#define PG8_UNI(p) (FP8 ? (const char*)(((unsigned long long)(unsigned)__builtin_amdgcn_readfirstlane((int)((unsigned long long)(p) >> 32)) << 32) | (unsigned long long)(unsigned)__builtin_amdgcn_readfirstlane((int)(unsigned long long)(p))) : (const char*)(p))
#define PG8_STAGE(bufoff, gbase, voff) do { const char* _gb = PG8_UNI(gbase); _Pragma("unroll") for (int _i = 0; _i < 2; ++_i) \
        __builtin_amdgcn_global_load_lds((const unsigned*)(_gb + (voff)[_i]), (PG8_LAS unsigned*)(lds + (bufoff) + ldsw + _i * 8192), 16, 0, 0); } while (0)
#define PG8_STAGE_A(bufoff, kbase, OFF, hf) do { const char* _gb = PG8_UNI(kbase); _Pragma("unroll") for (int _i = 0; _i < 2; ++_i) \
        __builtin_amdgcn_global_load_lds((const unsigned*)(_gb + (OFF)[hf][_i]), (PG8_LAS unsigned*)(lds + (bufoff) + ldsw + _i * 8192), 16, 0, 0); } while (0)
#define PG8_LDA(dst, b, h) do { _Pragma("unroll") for (int m = 0; m < 4; ++m) { const bf16x8 _l0 = *(const PG8_LAS bf16x8*)(lds + PG8_SA(b, h) + aoff + m * 2048), _l1 = *(const PG8_LAS bf16x8*)(lds + PG8_SA(b, h) + aoff + m * 2048 + 1024); \
        if constexpr (FP8) dst##8[m] = cat8(_l0, _l1); else { dst[m][0] = _l0; dst[m][1] = _l1; } } } while (0)
#define PG8_LDB(dst, b, h) do { _Pragma("unroll") for (int n = 0; n < 2; ++n) { const bf16x8 _l0 = *(const PG8_LAS bf16x8*)(lds + PG8_SB(b, h) + boff + n * 2048), _l1 = *(const PG8_LAS bf16x8*)(lds + PG8_SB(b, h) + boff + n * 2048 + 1024); \
        if constexpr (FP8) dst##8[n] = cat8(_l0, _l1); else { dst[n][0] = _l0; dst[n][1] = _l1; } } } while (0)
#define PG8_MMA(ai, bj, At, Bt) do { __builtin_amdgcn_s_setprio(1); _Pragma("unroll") for (int m = 0; m < 4; ++m) _Pragma("unroll") for (int n = 0; n < 2; ++n) { \
        if constexpr (FP8) acc[ai][bj][m][n] = __builtin_amdgcn_mfma_scale_f32_16x16x128_f8f6f4(Bt##8[n], At##8[m], acc[ai][bj][m][n], 0, 0, 0, SCW, 0, SCA); \
        else { _Pragma("unroll") for (int k = 0; k < 2; ++k) acc[ai][bj][m][n] = __builtin_amdgcn_mfma_f32_16x16x32_bf16(Bt[n][k], At[m][k], acc[ai][bj][m][n], 0, 0, 0); } } \
        if constexpr (FP8) asm volatile("" : "+v"(acc[ai][bj][0][0]), "+v"(acc[ai][bj][0][1]), "+v"(acc[ai][bj][1][0]), "+v"(acc[ai][bj][1][1]), "+v"(acc[ai][bj][2][0]), "+v"(acc[ai][bj][2][1]), "+v"(acc[ai][bj][3][0]), "+v"(acc[ai][bj][3][1]));   \
        __builtin_amdgcn_s_setprio(0); } while (0)
#define PG8_WAIT_V(n) asm volatile("s_waitcnt vmcnt(" #n ")" ::: "memory")
#define PG8_WAIT_L(n) asm volatile("s_waitcnt lgkmcnt(" #n ")" ::: "memory")
#define PG8_BAR __builtin_amdgcn_s_barrier()
#define PG8_SCHED __builtin_amdgcn_sched_barrier(0)
    Unit cur, nxt; int ui = 0;
    if (!S.next(0, cur)) return;
    f32x4 acc[2][2][4][2];
#pragma unroll
    for (int a = 0; a < 2; ++a)
#pragma unroll
        for (int b = 0; b < 2; ++b)
#pragma unroll
            for (int m = 0; m < 4; ++m)
#pragma unroll
                for (int n = 0; n < 2; ++n) acc[a][b][m][n] = (f32x4){0.f, 0.f, 0.f, 0.f};
    bf16x8 At[4][2], B0[2][2], B1[2][2]; v8i_t At8[4], B08[2], B18[2];
    const char* const kA = (const char*)g.A; const char* cB = (const char*)g.Bt + (size_t)cur.pn * tstep;
    unsigned curOff[2][2];
#pragma unroll
    for (int hf = 0; hf < 2; ++hf)
#pragma unroll
        for (int i = 0; i < 2; ++i) { curOff[hf][i] = rowoff[cur.pm * BM + hf * HALF + rowA[i]] + colA[i]; }
    S.a_ready(cur);
    if constexpr (SP2) {
        PG8_STAGE(PG8_SB(0, 0), cB, voffB); PG8_STAGE(PG8_SB(0, 1), cB + hstep, voffB); PG8_STAGE_A(PG8_SA(0, 0), kA, curOff, 0); PG8_STAGE_A(PG8_SA(0, 1), kA, curOff, 1);
        if (wr == 1) PG8_BAR;
        PG8_WAIT_V(2); PG8_BAR;
        PG8_STAGE(PG8_SB(1, 0), cB + kstep, voffB); PG8_STAGE_A(PG8_SA(1, 0), kA + kstep, curOff, 0); PG8_STAGE(PG8_SB(1, 1), cB + hstep + kstep, voffB);
        PG8_WAIT_V(6); PG8_BAR;
    }
    for (;;) {
        const bool has_next = S.next(ui + 1, nxt);
        if constexpr (Epi::ROWSCALE) { if (wid >= 4) __builtin_amdgcn_global_load_lds((const unsigned*)(E.rs + cur.pm * BM + (wid - 4) * 64 + lane), (PG8_LAS unsigned*)(E.rsl + (wid - 4) * 64), 4, 0, 0); }
        const char* nB = has_next ? (const char*)g.Bt + (size_t)nxt.pn * tstep : cB;
        int dma_pending = has_next ? 1 : 0; asm volatile("" : "+v"(dma_pending));
        for (int t = 0; t < nt; t += 2) {
            const bool last = (t == nt - 2);
            if constexpr (FP8) {
                int t_ = tid; asm volatile("" : "+v"(t_));
#pragma unroll
                for (int i = 0; i < 2; ++i) { int R, C; stage_rc(t_ * 16 + i * 8192, R, C); const int Rb = Epi::PERM ? ((R & ~31) + perm32(R & 31)) : R;
                    voffA[i] = (unsigned)(R * K + C) * 2u; voffB[i] = (unsigned)(Rb * K + C) * 2u; rowA[i] = R; colA[i] = (unsigned)C * 2u; }
                const int fr_ = t_ & 15, fq_ = (t_ & 63) >> 4; aoff = lds_byte(wr * 64 + fr_, fq_ * 8); boff = lds_byte(wc * 32 + fr_, fq_ * 8); }
            const char* a1 = kA + (size_t)(t + 1) * kstep;
            const char* a2 = last ? kA : kA + (size_t)(t + 2) * kstep; const char* b2 = last ? nB : cB + (size_t)(t + 2) * kstep;
            unsigned o2[2][2];
#pragma unroll
            for (int hf = 0; hf < 2; ++hf)
#pragma unroll
                for (int i = 0; i < 2; ++i) o2[hf][i] = (last && has_next) ? tab[hf * HALF + rowA[i]] + colA[i] : curOff[hf][i];
            const char* a3 = a2 + kstep; const char* b3 = b2 + kstep;
            if (last && has_next) S.a_ready(nxt);
            if constexpr (SP2) {
            PG8_LDB(B0, 0, 0); PG8_LDB(B1, 0, 1); PG8_SCHED; PG8_LDA(At, 0, 0); PG8_STAGE_A(PG8_SA(1, 1), a1, curOff, 1);
            PG8_WAIT_V(8); PG8_WAIT_L(0); PG8_BAR;
            if (dma_pending && wid < 4) __builtin_amdgcn_global_load_lds(rowoff + nxt.pm * BM + wid * 64 + lane, (PG8_LAS unsigned*)(tab + wid * 64), 4, 0, 0);
            dma_pending = 0; asm volatile("" : "+v"(dma_pending));
            PG8_MMA(0, 0, At, B0); PG8_MMA(0, 1, At, B1); PG8_BAR; PG8_SCHED;
            PG8_LDA(At, 0, 1); PG8_STAGE(PG8_SB(0, 0), b2, voffB); PG8_STAGE(PG8_SB(0, 1), b2 + hstep, voffB); PG8_STAGE_A(PG8_SA(0, 0), a2, o2, 0);
            PG8_WAIT_V(8); PG8_WAIT_L(0); PG8_BAR; PG8_MMA(1, 0, At, B0); PG8_MMA(1, 1, At, B1); PG8_BAR; PG8_SCHED;
            PG8_LDB(B0, 1, 0); PG8_LDB(B1, 1, 1); PG8_SCHED; PG8_LDA(At, 1, 0); PG8_STAGE_A(PG8_SA(0, 1), a2, o2, 1);
            PG8_WAIT_V(8); PG8_WAIT_L(0); PG8_BAR; PG8_MMA(0, 0, At, B0); PG8_MMA(0, 1, At, B1); PG8_BAR; PG8_SCHED;
            PG8_LDA(At, 1, 1); PG8_STAGE(PG8_SB(1, 0), b3, voffB); PG8_STAGE(PG8_SB(1, 1), b3 + hstep, voffB); PG8_STAGE_A(PG8_SA(1, 0), a3, o2, 0);
            PG8_WAIT_V(8); PG8_WAIT_L(0); PG8_BAR; PG8_MMA(1, 0, At, B0); PG8_MMA(1, 1, At, B1); PG8_BAR; PG8_SCHED;
            }
        }
        if constexpr (ALIGN_EPI) { if (wr == 0) PG8_BAR; }
        if constexpr (!Epi::AFTER_DRAIN) { E(acc, cur, wr, wc, fr, fq); S.done(cur); }
        if (!has_next) break;
#pragma unroll
        for (int a = 0; a < 2; ++a)
#pragma unroll
            for (int b = 0; b < 2; ++b)
#pragma unroll
                for (int m = 0; m < 4; ++m)
#pragma unroll
                    for (int n = 0; n < 2; ++n) acc[a][b][m][n] = (f32x4){0.f, 0.f, 0.f, 0.f};
        cur = nxt; cB = nB; ++ui;
#pragma unroll
        for (int hf = 0; hf < 2; ++hf)
#pragma unroll
            for (int i = 0; i < 2; ++i) curOff[hf][i] = tab[hf * HALF + rowA[i]] + colA[i];
        if constexpr (ALIGN_EPI) { if (wr == 1) PG8_BAR; }
    }
    PG8_WAIT_V(0);
    if constexpr (!ALIGN_EPI) { if (wr == 0) PG8_BAR; }
    PG8_BAR;
    if constexpr (Epi::AFTER_DRAIN) { E.fused(acc, cur, wr, wc, fr, fq, lds, wid, lane); S.done(cur); }
#undef PG8_SA
#undef PG8_SB
#undef PG8_STAGE
#undef PG8_UNI
#undef PG8_STAGE_A
#undef PG8_LDA
#undef PG8_LDB
#undef PG8_MMA
#undef PG8_WAIT_V
#undef PG8_WAIT_L
#undef PG8_BAR
#undef PG8_SCHED
}

}
#define GAS __attribute__((address_space(1)))
#define LAS __attribute__((address_space(3)))
typedef unsigned short bf16;
typedef unsigned v4u __attribute__((ext_vector_type(4)));
typedef unsigned v2u __attribute__((ext_vector_type(2)));
typedef float f32x4 __attribute__((ext_vector_type(4)));
constexpr int BATCH = 8, SEQ = 4096, D = 1024, T = BATCH * SEQ;
constexpr int GH = 4, DK = 128, DV = 256, QKD = 512, GR = 16, AIN = 3088, CH = 64, NCH = SEQ / CH;
constexpr int SBH = 16, SBD = 64;
constexpr int NE = 16, DE = 512, NPROJ = 3072;
constexpr float EPS = 1e-6f;
constexpr int MAXTILES = T * 2 / 256 + NE, XROWS = MAXTILES * 256;
constexpr size_t MiB = 1u << 20;
constexpr size_t WS_CTL = 0, CTL_ZERO_BYTES = 64 * 1024;
constexpr size_t WS_WIN = 2 * MiB, WS_WAO = 8 * MiB, WS_WQKV = 10 * MiB, WS_WBO = 16 * MiB, WS_W1 = 18 * MiB, WS_W2 = 82 * MiB;
constexpr size_t WS_PROJ = 114 * MiB;
constexpr size_t WS_U = 306 * MiB;
constexpr size_t WS_HDN = 114 * MiB;
constexpr size_t WS_H8 = 434 * MiB;
constexpr size_t WS_Y = 182 * MiB;
constexpr size_t WS_ST = 370 * MiB;
constexpr size_t WS_H = 370 * MiB;
constexpr size_t WS_GKLR = 506 * MiB;
constexpr size_t WS_TOK = 508 * MiB;
constexpr size_t WS_RS1 = 509 * MiB;
constexpr size_t WS_RS2 = 509 * MiB + 288 * 1024;
constexpr size_t WS_ROWOFF = 509 * MiB + 576 * 1024;
constexpr size_t WS_ROWID = 511 * MiB + 512 * 1024;
constexpr size_t WS_RSTD = 511 * MiB + 128 * 1024;
constexpr size_t WS_END = 512 * MiB;
constexpr int CW_CNT = 64;
constexpr int CW_CUR = 256;
constexpr int CW_BAR = 4096;

__device__ __forceinline__ unsigned f2bf(float f) { unsigned u = __builtin_bit_cast(unsigned, f); return (u + 0x7fffu + ((u >> 16) & 1u)) >> 16; }
__device__ __forceinline__ unsigned pk2(float lo, float hi) { return f2bf(lo) | (f2bf(hi) << 16); }
__device__ __forceinline__ float bf2f(unsigned short b) { return __builtin_bit_cast(float, (unsigned)b << 16); }
__device__ __forceinline__ float bflo(unsigned w) { return __builtin_bit_cast(float, w << 16); }
__device__ __forceinline__ float bfhi(unsigned w) { return __builtin_bit_cast(float, w & 0xffff0000u); }
__device__ __forceinline__ float wave_sum(float v) {
#pragma unroll
    for (int o = 1; o < 64; o <<= 1) v += __shfl_xor(v, o);
    return v;
}
__device__ __forceinline__ float logsigmoidf_(float x) { return fminf(x, 0.f) - log1pf(__expf(-fabsf(x))); }
__device__ __forceinline__ float softplusf_(float x) { return fmaxf(x, 0.f) + log1pf(__expf(-fabsf(x))); }

struct TItem { const float* src; const float* gain; bf16* dst; int ldw, K; float scale; int fp8; };
__device__ __forceinline__ void ti_load(const TItem& t, int lane, float (&wv)[32], f32x4& g0, f32x4& g1) {
    g0 = (f32x4){1.f, 1.f, 1.f, 1.f}; g1 = g0;
    if (t.gain) { g0 = *(const f32x4*)(t.gain + 8 * (lane & 7)); g1 = *(const f32x4*)(t.gain + 8 * (lane & 7) + 4); }
    const float* wp = t.src + (size_t)(lane >> 5) * t.ldw + (lane & 31);
#pragma unroll
    for (int i = 0; i < 32; ++i) wv[i] = wp[(size_t)(2 * i) * t.ldw];
}
__device__ __forceinline__ void ti_process(const TItem& t, int lane, const float (&wv)[32], f32x4 g0, f32x4 g1, LAS float* scr) {
#pragma unroll
    for (int i = 0; i < 32; ++i) scr[(2 * i + (lane >> 5)) * 33 + (lane & 31)] = wv[i];
    __builtin_amdgcn_wave_barrier(); asm volatile("s_waitcnt lgkmcnt(0)" ::: "memory");
    const int c = lane & 7; g0 = g0 * t.scale; g1 = g1 * t.scale;
    if (t.fp8) {
#pragma unroll
        for (int j = 0; j < 4; ++j) { const int n = (lane >> 3) + 8 * j; const LAS float* s = scr + (8 * c) * 33 + n;
            v2u o; o.x = pg8::pk_fp8x4(s[0 * 33] * g0.x, s[1 * 33] * g0.y, s[2 * 33] * g0.z, s[3 * 33] * g0.w); o.y = pg8::pk_fp8x4(s[4 * 33] * g1.x, s[5 * 33] * g1.y, s[6 * 33] * g1.z, s[7 * 33] * g1.w);
            *(v2u*)((unsigned char*)t.dst + (size_t)n * t.K + 8 * c) = o; }
    } else {
#pragma unroll
        for (int j = 0; j < 4; ++j) { const int n = (lane >> 3) + 8 * j; const LAS float* s = scr + (8 * c) * 33 + n;
            v4u o; o.x = pk2(s[0 * 33] * g0.x, s[1 * 33] * g0.y); o.y = pk2(s[2 * 33] * g0.z, s[3 * 33] * g0.w); o.z = pk2(s[4 * 33] * g1.x, s[5 * 33] * g1.y); o.w = pk2(s[6 * 33] * g1.z, s[7 * 33] * g1.w);
            *(v4u*)(t.dst + (size_t)n * t.K + 8 * c) = o; }
    }
    __builtin_amdgcn_wave_barrier(); asm volatile("s_waitcnt lgkmcnt(0)" ::: "memory");
}
struct In {
    const float *x, *a_norm, *a_w_in, *a_w_gk2, *a_b_gk2, *a_o_norm, *a_w_out, *kv_norm, *w_kv, *b_norm, *b_w_q, *b_w_out, *m_norm, *m_w_group, *m_b_group, *m_w_expert, *m_b_expert, *m_w_gate, *m_w_up, *m_w_down, *final_norm;
};
constexpr float W8_SCALE = 8.f, A8_SCALE = 8.f;
constexpr int IT_WIN = 16 * 96, IT_AO = 16 * 32, IT_Q = 16 * 32, IT_KV = 16 * 64, IT_BO = 16 * 32, IT_W1 = 32 * 16 * 32, IT_W2 = 32 * 8 * 32;
constexpr int IT_TOTAL = IT_WIN + IT_AO + IT_Q + IT_KV + IT_BO + IT_W1 + IT_W2, IT_L1 = IT_TOTAL - (IT_W1 + IT_W2) / 2;
__device__ __forceinline__ TItem make_item(const In& in, unsigned char* ws, int it) {
    TItem t; t.fp8 = 0; int r = it;
    if (r < IT_WIN) { const int kb = r / 96, nb = r % 96, n0 = nb * 32, k0 = kb * 64; t.src = in.a_w_in + (size_t)k0 * AIN + n0 + (n0 >= 2048 ? 16 : 0); t.ldw = AIN; t.gain = in.a_norm + k0; t.scale = n0 < QKD ? 0.08838834764831845f : 1.f; t.dst = (bf16*)(ws + WS_WIN) + (size_t)n0 * D + k0; t.K = D; return t; } r -= IT_WIN;
    if (r < IT_AO) { const int kb = r / 32, nb = r % 32, k0 = kb * 64; t.src = in.a_w_out + (size_t)k0 * D + nb * 32; t.ldw = D; t.gain = in.a_o_norm + (k0 & (DV - 1)); t.scale = 1.f; t.dst = (bf16*)(ws + WS_WAO) + (size_t)(nb * 32) * D + k0; t.K = D; return t; } r -= IT_AO;
    if (r < IT_Q) { const int kb = r / 32, nb = r % 32, k0 = kb * 64; t.src = in.b_w_q + (size_t)k0 * D + nb * 32; t.ldw = D; t.gain = in.b_norm + k0; t.scale = 0.125f * 1.4426950408889634f; t.dst = (bf16*)(ws + WS_WQKV) + (size_t)(nb * 32) * D + k0; t.K = D; return t; } r -= IT_Q;
    if (r < IT_KV) { const int kb = r / 64, nb = r % 64, k0 = kb * 64; t.src = in.w_kv + (size_t)k0 * (2 * D) + nb * 32; t.ldw = 2 * D; t.gain = in.kv_norm + k0; t.scale = 1.f; t.dst = (bf16*)(ws + WS_WQKV) + (size_t)(D + nb * 32) * D + k0; t.K = D; return t; } r -= IT_KV;
    if (r < IT_BO) { const int kb = r / 32, nb = r % 32, k0 = kb * 64; t.src = in.b_w_out + (size_t)k0 * D + nb * 32; t.ldw = D; t.gain = nullptr; t.scale = 1.f; t.dst = (bf16*)(ws + WS_WBO) + (size_t)(nb * 32) * D + k0; t.K = D; return t; } r -= IT_BO;
    { const int l = r >= (IT_W1 + IT_W2) / 2 ? 1 : 0; r -= l * ((IT_W1 + IT_W2) / 2);
      if (r < IT_W1 / 2) { const int le = l * 16 + r / 512, q = r % 512, kb = q / 32, nb = q % 32, vr0 = nb * 32, pn = vr0 >> 8, bj = (vr0 >> 7) & 1, r0 = vr0 & 127, k0 = kb * 64;
        t.src = (bj ? in.m_w_up : in.m_w_gate) + (size_t)le * D * DE + (size_t)k0 * DE + 128 * pn + r0; t.ldw = DE; t.gain = in.m_norm + l * D + k0; t.scale = W8_SCALE; t.fp8 = 1; t.dst = (bf16*)(ws + WS_W1 + (size_t)le * 1024 * D + (size_t)vr0 * D + k0); t.K = D; return t; }
      r -= IT_W1 / 2;
      { const int le = l * 16 + r / 256, q = r % 256, kb = q / 32, nb = q % 32, k0 = kb * 64;
        t.src = in.m_w_down + (size_t)le * DE * D + (size_t)k0 * D + nb * 32; t.ldw = D; t.gain = nullptr; t.scale = W8_SCALE; t.fp8 = 1; t.dst = (bf16*)(ws + WS_W2 + (size_t)le * 1024 * DE + (size_t)(nb * 32) * DE + k0); t.K = DE; return t; } }
}
__device__ __forceinline__ void prologue_items(const In& in, unsigned char* ws, LAS float* scr, int gw, int ngw, int lane, int it0, int it1) {
    if (it0 + gw >= it1) return;
    TItem cur = make_item(in, ws, it0 + gw); float wa[32]; f32x4 ga0, ga1; ti_load(cur, lane, wa, ga0, ga1);
    for (int it = it0 + gw; it < it1; it += ngw) {
        const int nx = it + ngw; const bool has = nx < it1; const TItem nxt = make_item(in, ws, has ? nx : it); float wb[32]; f32x4 gb0, gb1; ti_load(nxt, lane, wb, gb0, gb1);
        ti_process(cur, lane, wa, ga0, ga1, scr);
        cur = nxt; ga0 = gb0; ga1 = gb1;
#pragma unroll
        for (int i = 0; i < 32; ++i) wa[i] = wb[i];
    }
}
__device__ __forceinline__ void load_row(const float* row, int lane, f32x4 (&v)[4]) {
#pragma unroll
    for (int j = 0; j < 4; ++j) v[j] = *(const f32x4*)(row + 256 * j + 4 * lane);
}
__device__ __forceinline__ void load_row_bf16(const bf16* row, int lane, f32x4 (&v)[4]) {
#pragma unroll
    for (int j = 0; j < 4; ++j) { const uint2 o = *(const uint2*)(row + 256 * j + 4 * lane); v[j].x = bflo(o.x); v[j].y = bfhi(o.x); v[j].z = bflo(o.y); v[j].w = bfhi(o.y); }
}
__device__ __forceinline__ float row_ssq(const f32x4 (&v)[4]) { float s = 0.f;
#pragma unroll
    for (int j = 0; j < 4; ++j) s += (v[j].x * v[j].x + v[j].y * v[j].y) + (v[j].z * v[j].z + v[j].w * v[j].w);
    return wave_sum(s); }
__device__ __forceinline__ void store_row_bf16(bf16* row, int lane, const f32x4 (&v)[4], float s) {
#pragma unroll
    for (int j = 0; j < 4; ++j) { uint2 o; o.x = pk2(v[j].x * s, v[j].y * s); o.y = pk2(v[j].z * s, v[j].w * s); *(uint2*)(row + 256 * j + 4 * lane) = o; }
}
__device__ __forceinline__ void add_row_bf16(const bf16* row, int lane, f32x4 (&v)[4]) {
#pragma unroll
    for (int j = 0; j < 4; ++j) { const uint2 o = *(const uint2*)(row + 256 * j + 4 * lane); v[j].x += bflo(o.x); v[j].y += bfhi(o.x); v[j].z += bflo(o.y); v[j].w += bfhi(o.y); }
}
template <int C> __device__ __forceinline__ float row_dots2(const f32x4 (&va)[4], const f32x4 (&vb)[4], const LAS float* Wl, int lane) {
    float res = 0.f; const bool up5 = (lane & 32) != 0, up4 = (lane & 16) != 0;
    typedef float f32x2v __attribute__((ext_vector_type(2)));
#pragma unroll 1
    for (int cp = 0; cp < C / 2; ++cp) { f32x2v pa0 = {0.f, 0.f}, pa1 = pa0, pb0 = pa0, pb1 = pa0; const LAS float* wp = Wl + cp * 2048 + 4 * lane;
#pragma unroll
        for (int j = 0; j < 4; ++j) { const f32x4 w0 = *(const LAS f32x4*)(wp + 256 * j), w1 = *(const LAS f32x4*)(wp + 1024 + 256 * j);
            const f32x2v w0l = {w0.x, w0.y}, w0h = {w0.z, w0.w}, w1l = {w1.x, w1.y}, w1h = {w1.z, w1.w}, al = {va[j].x, va[j].y}, ah = {va[j].z, va[j].w}, bl = {vb[j].x, vb[j].y}, bh = {vb[j].z, vb[j].w};
            pa0 += al * w0l; pa0 += ah * w0h; pa1 += al * w1l; pa1 += ah * w1h; pb0 += bl * w0l; pb0 += bh * w0h; pb1 += bl * w1l; pb1 += bh * w1h; }
        const float a0 = pa0.x + pa0.y, a1 = pa1.x + pa1.y, b0 = pb0.x + pb0.y, b1 = pb1.x + pb1.y;
        const float k0 = up5 ? b0 : a0, k1 = up5 ? b1 : a1, s0 = up5 ? a0 : b0, s1 = up5 ? a1 : b1;
        const float w0 = k0 + __shfl_xor(s0, 32), w1 = k1 + __shfl_xor(s1, 32);
        float u = (up4 ? w1 : w0) + __shfl_xor(up4 ? w0 : w1, 16);
        u += __shfl_xor(u, 8); u += __shfl_xor(u, 4); u += __shfl_xor(u, 2); u += __shfl_xor(u, 1);
        res = ((lane & 15) == cp) ? u : res; }
    return res;
}
__device__ __forceinline__ void row_ssq2(const f32x4 (&va)[4], const f32x4 (&vb)[4], int lane, float& sa, float& sb) {
    float a = 0.f, b = 0.f;
#pragma unroll
    for (int j = 0; j < 4; ++j) { a += (va[j].x * va[j].x + va[j].y * va[j].y) + (va[j].z * va[j].z + va[j].w * va[j].w); b += (vb[j].x * vb[j].x + vb[j].y * vb[j].y) + (vb[j].z * vb[j].z + vb[j].w * vb[j].w); }
    const bool up5 = (lane & 32) != 0;
    float u = (up5 ? b : a) + __shfl_xor(up5 ? a : b, 32);
    u += __shfl_xor(u, 16); u += __shfl_xor(u, 8); u += __shfl_xor(u, 4); u += __shfl_xor(u, 2); u += __shfl_xor(u, 1);
    sa = __shfl(u, 0); sb = __shfl(u, 32);
}
__device__ __forceinline__ void ph_norm_in(const In& in, unsigned char* ws, LAS float* Wl) {
    { f32x4 w4[2][4]; float gk[2];
#pragma unroll
      for (int q = 0; q < 2; ++q) { const int k = TIDX + 512 * q; gk[q] = in.a_norm[k];
#pragma unroll
          for (int j = 0; j < 4; ++j) w4[q][j] = *(const f32x4*)(in.a_w_in + (size_t)k * AIN + 2048 + 4 * j); }
#pragma unroll
      for (int q = 0; q < 2; ++q) { const int k = TIDX + 512 * q;
#pragma unroll
          for (int c = 0; c < 16; ++c) Wl[c * 1024 + k] = gk[q] * w4[q][c >> 2][c & 3]; } }
    __syncthreads();
    const int lane = TIDX & 63, w = TIDX >> 6; bf16* U = (bf16*)(ws + WS_U); float* gklr = (float*)(ws + WS_GKLR);
    const int rbeg = blockIdx.x * 128 + w * 16;
    f32x4 va[4], vb[4]; load_row(in.x + (size_t)rbeg * D, lane, va); load_row(in.x + (size_t)(rbeg + 1) * D, lane, vb);
    for (int row = rbeg; row < rbeg + 16; row += 2) {
        const int rn = row + 2 < rbeg + 16 ? row + 2 : row; f32x4 na[4], nb[4]; load_row(in.x + (size_t)rn * D, lane, na); load_row(in.x + (size_t)(rn + 1) * D, lane, nb);
        float sa, sb; row_ssq2(va, vb, lane, sa, sb);
        const float ra = rsqrtf(sa * (1.f / D) + EPS), rb = rsqrtf(sb * (1.f / D) + EPS);
        store_row_bf16(U + (size_t)row * D, lane, va, ra); store_row_bf16(U + (size_t)(row + 1) * D, lane, vb, rb);
        const float pr = row_dots2<16>(va, vb, Wl, lane);
        if ((lane & 15) < 8) { const int cls = lane >> 4, col = 2 * (lane & 15) + (cls & 1); gklr[(size_t)(row + (cls >> 1)) * 16 + col] = pr * ((cls >> 1) ? rb : ra); }
#pragma unroll
        for (int j = 0; j < 4; ++j) { va[j] = na[j]; vb[j] = nb[j]; }
    }
}
struct TokRec { int e0, e1; float w0, w1; float rstd; int p0, p1; int pad; };
constexpr size_t WS_WGCNT = 511 * MiB;
typedef short rbf16x8 __attribute__((ext_vector_type(8)));
__device__ __forceinline__ void ph_router(const In& in, unsigned char* ws, const bf16* h, int layer, LAS unsigned char* lds) {
    constexpr int RSW = 2064;
    const float* gn = in.m_norm + layer * D; const float* wg = in.m_w_group + (size_t)layer * D * 4; const float* we = in.m_w_expert + (size_t)layer * D * NE;
    { f32x4 w4[2][5]; float gk[2];
#pragma unroll
      for (int q = 0; q < 2; ++q) { const int k = TIDX + 512 * q; gk[q] = gn[k]; w4[q][0] = *(const f32x4*)(wg + k * 4);
#pragma unroll
          for (int j = 0; j < 4; ++j) w4[q][1 + j] = *(const f32x4*)(we + k * NE + 4 * j); }
#pragma unroll
      for (int q = 0; q < 2; ++q) { const int k = TIDX + 512 * q;
#pragma unroll
          for (int c = 0; c < 20; ++c) { const float wv = gk[q] * w4[q][c >> 2][c & 3];
              const unsigned hi = f2bf(wv), lo = f2bf(wv - bf2f((unsigned short)hi)); *(LAS unsigned short*)(lds + c * RSW + k * 2) = (unsigned short)hi; *(LAS unsigned short*)(lds + (20 + c) * RSW + k * 2) = (unsigned short)lo; } } }
    for (int i = TIDX; i < 8 * 1024; i += 512) *(LAS unsigned short*)(lds + (40 + (i >> 10)) * RSW + (i & 1023) * 2) = 0;
    __syncthreads();
    const int lane = TIDX & 63, w = TIDX >> 6, r16 = lane & 15, kq = lane >> 4; TokRec* tok = (TokRec*)(ws + WS_TOK);
    LAS int* wcnt = (LAS int*)(lds + 48 * RSW); LAS float* lg = (LAS float*)(lds + 48 * RSW + 512) + w * (16 * 48);
    const float* bg = in.m_b_group + layer * 4; const float* be = in.m_b_expert + layer * NE;
    const int rowbase = blockIdx.x * 128 + w * 16;
    float rstd;
    { const bf16* hp = h + (size_t)(rowbase + r16) * D + 16 * kq;
      rbf16x8 a[32];
#pragma unroll
      for (int s = 0; s < 32; ++s) a[s] = *(const rbf16x8*)(hp + 64 * (s >> 1) + 8 * (s & 1));
      f32x4 acc[3]; acc[0] = (f32x4){0.f, 0.f, 0.f, 0.f}; acc[1] = acc[0]; acc[2] = acc[0]; float ssq = 0.f;
#pragma unroll
      for (int s = 0; s < 32; ++s) {
#pragma unroll
          for (int t = 0; t < 3; ++t) { const rbf16x8 B = *(const LAS rbf16x8*)(lds + (16 * t + r16) * RSW + (64 * (s >> 1) + 16 * kq + 8 * (s & 1)) * 2); acc[t] = __builtin_amdgcn_mfma_f32_16x16x32_bf16(a[s], B, acc[t], 0, 0, 0); }
          if ((s & 1) == 1) asm volatile("" ::: "memory");
          const v4u u = __builtin_bit_cast(v4u, a[s]);
          ssq += (bflo(u.x) * bflo(u.x) + bfhi(u.x) * bfhi(u.x)) + (bflo(u.y) * bflo(u.y) + bfhi(u.y) * bfhi(u.y)) + (bflo(u.z) * bflo(u.z) + bfhi(u.z) * bfhi(u.z)) + (bflo(u.w) * bflo(u.w) + bfhi(u.w) * bfhi(u.w)); }
      ssq += __shfl_xor(ssq, 16); ssq += __shfl_xor(ssq, 32);
      rstd = rsqrtf(ssq * (1.f / D) + EPS);
      { unsigned char* h8 = ws + WS_H8 + (size_t)(rowbase + r16) * D + 16 * kq; const float q8 = rstd * A8_SCALE;
#pragma unroll
        for (int s2 = 0; s2 < 16; ++s2) { v4u u = __builtin_bit_cast(v4u, a[2 * s2]), u2 = __builtin_bit_cast(v4u, a[2 * s2 + 1]); asm volatile("" : "+v"(u), "+v"(u2));
            v4u o; o.x = pg8::pk_fp8x4_nc(bflo(u.x) * q8, bfhi(u.x) * q8, bflo(u.y) * q8, bfhi(u.y) * q8); o.y = pg8::pk_fp8x4_nc(bflo(u.z) * q8, bfhi(u.z) * q8, bflo(u.w) * q8, bfhi(u.w) * q8);
            o.z = pg8::pk_fp8x4_nc(bflo(u2.x) * q8, bfhi(u2.x) * q8, bflo(u2.y) * q8, bfhi(u2.y) * q8); o.w = pg8::pk_fp8x4_nc(bflo(u2.z) * q8, bfhi(u2.z) * q8, bflo(u2.w) * q8, bfhi(u2.w) * q8);
            *(v4u*)(h8 + 64 * s2) = o; } }
#pragma unroll
      for (int t = 0; t < 3; ++t)
#pragma unroll
          for (int rg = 0; rg < 4; ++rg) lg[(4 * kq + rg) * 48 + 16 * t + r16] = acc[t][rg];
    }
    int re0, re1, rk0 = 0, rk1 = 0; float rw0, rw1, rrs; int cnt = 0;
    { const int ri = lane & 15; float p[20];
#pragma unroll
        for (int c = 0; c < 20; ++c) p[c] = lg[ri * 48 + c] + lg[ri * 48 + 20 + c];
        float gl[4]; int g = 0; float gmax;
#pragma unroll
        for (int c = 0; c < 4; ++c) gl[c] = p[c] * rstd + bg[c];
        gmax = gl[0];
#pragma unroll
        for (int c = 1; c < 4; ++c) if (gl[c] > gmax) { gmax = gl[c]; g = c; }
        float gsum = 0.f;
#pragma unroll
        for (int c = 0; c < 4; ++c) gsum += __expf(gl[c] - gmax);
        const float gw = 1.f / gsum;
        float sel[4];
#pragma unroll
        for (int j = 0; j < 4; ++j) { float s = p[4 + j] * rstd + be[j];
#pragma unroll
            for (int gg = 1; gg < 4; ++gg) { const float s2 = p[4 + 4 * gg + j] * rstd + be[4 * gg + j]; s = (g == gg) ? s2 : s; }
            sel[j] = s; }
        int i1 = 0; float s1 = sel[0];
#pragma unroll
        for (int j = 1; j < 4; ++j) if (sel[j] > s1) { s1 = sel[j]; i1 = j; }
        int i2 = -1; float s2 = -3.0e38f;
#pragma unroll
        for (int j = 0; j < 4; ++j) if (j != i1 && sel[j] > s2) { s2 = sel[j]; i2 = j; }
        const float r = __expf(s2 - s1), w1 = gw / (1.f + r), w2 = gw * r / (1.f + r);
        const int e0 = 4 * g + i1, e1 = 4 * g + i2;
        re0 = e0; re1 = e1; rw0 = w1; rw1 = w2; rrs = rstd;
#pragma unroll
        for (int e = 0; e < 16; ++e) { const unsigned long long m = __ballot(lane < 16 && (e0 == e || e1 == e)); const int below = __popcll(m & ((1ull << lane) - 1ull));
            rk0 = (e0 == e) ? below : rk0; rk1 = (e1 == e) ? below : rk1; cnt = (lane == e) ? (int)__popcll(m) : cnt; }
    }
    if (lane < 16) wcnt[w * 16 + lane] = cnt;
    __syncthreads();
    if (lane < 16) { int a0 = 0, a1 = 0;
        for (int ww = 0; ww < w; ++ww) { a0 += wcnt[ww * 16 + re0]; a1 += wcnt[ww * 16 + re1]; }
        TokRec t; t.e0 = re0; t.e1 = re1; t.w0 = rw0; t.w1 = rw1; t.rstd = rrs; t.p0 = a0 + rk0; t.p1 = a1 + rk1; t.pad = 0; tok[blockIdx.x * 128 + w * 16 + lane] = t; }
    if (TIDX < 16) { int tot = 0;
        for (int ww = 0; ww < 8; ++ww) tot += wcnt[ww * 16 + TIDX];
        ((int*)(ws + WS_WGCNT))[(layer * 256 + blockIdx.x) * 16 + TIDX] = tot; }
}
__device__ __forceinline__ void ph_positions(unsigned char* ws, int layer, LAS int* sm) {
    const int tid = TIDX; TokRec* tok = (TokRec*)(ws + WS_TOK);
    const int* wgc = (const int*)(ws + WS_WGCNT) + layer * 256 * 16; LAS int* tbl = sm; LAS int* part = sm + 4096; LAS int* basee = sm + 4096 + 512;
    { int v[8];
#pragma unroll
      for (int i = 0; i < 8; ++i) v[i] = wgc[tid + 512 * i];
#pragma unroll
      for (int i = 0; i < 8; ++i) tbl[tid + 512 * i] = v[i]; }
    __syncthreads();
    if (tid < 256) { const int e = tid & 15, seg = tid >> 4; int s = 0, bl = 0;
        for (int i = 0; i < 16; ++i) { const int blk = seg * 16 + i; const int v = tbl[blk * 16 + e]; s += v; bl += (blk < (int)blockIdx.x) ? v : 0; }
        part[tid] = s; part[256 + tid] = bl; }
    __syncthreads();
    if (tid < 16) { int tot = 0, bl = 0;
        for (int seg = 0; seg < 16; ++seg) { tot += part[seg * 16 + tid]; bl += part[256 + seg * 16 + tid]; }
        basee[16 + tid] = tot; basee[32 + tid] = bl; }
    __syncthreads();
    if (tid == 0) { int a = 0;
        for (int e = 0; e < 16; ++e) { basee[48 + e] = a; basee[e] = a + basee[32 + e]; a += ((basee[16 + e] + 255) >> 8) << 8; } }
    if (blockIdx.x == 0 && tid < 16) ((unsigned*)(ws + WS_CTL))[CW_CNT + 64 * layer + tid] = (unsigned)basee[16 + tid];
    __syncthreads();
    float* rs1 = (float*)(ws + WS_RS1); float* rs2 = (float*)(ws + WS_RS2); unsigned* rowoff = (unsigned*)(ws + WS_ROWOFF);
    { const int gi = blockIdx.x * 512 + tid; if (gi < XROWS) ((unsigned*)(ws + WS_ROWID))[gi] = (unsigned)gi * DE; }
    if (tid < 128) { const int row = blockIdx.x * 128 + tid; TokRec t = tok[row]; const int p0 = basee[t.e0] + t.p0, p1 = basee[t.e1] + t.p1;
        tok[row].p0 = p0; tok[row].p1 = p1; rowoff[p0] = (unsigned)row * D; rowoff[p1] = (unsigned)row * D; rs1[p0] = t.rstd; rs1[p1] = t.rstd; rs2[p0] = t.w0; rs2[p1] = t.w1; }
    if (blockIdx.x < 16) { const int e = blockIdx.x, tot = basee[16 + e], o = basee[48 + e], npad = (((tot + 255) >> 8) << 8) - tot;
        for (int i = tid; i < npad; i += 512) { rowoff[o + tot + i] = 0u; rs1[o + tot + i] = 0.f; rs2[o + tot + i] = 0.f; } }
}
__device__ __forceinline__ void ph_combine(const In& in, unsigned char* ws, float* out, int MODE) {
    const int lane = TIDX & 63, w = TIDX >> 6; const TokRec* tok = (const TokRec*)(ws + WS_TOK);
    const unsigned char* Y = ws + WS_Y; bf16* H = (bf16*)(ws + WS_H); float* rstd = (float*)(ws + WS_RSTD);
    const int rowbase = blockIdx.x * 128 + w * 16;
    int pp0 = 0, pp1 = 0; if (lane < 16) { pp0 = tok[rowbase + lane].p0; pp1 = tok[rowbase + lane].p1; }
    f32x4 gfin[4];
    if (MODE != 0) {
#pragma unroll
        for (int j = 0; j < 4; ++j) gfin[j] = *(const f32x4*)(in.final_norm + 256 * j + 4 * lane); }
    v2u ha[4], hb[4]; unsigned ya0[4], ya1[4], yb0[4], yb1[4];
#define COMBINE_LOAD(i16n) do { const int _r = rowbase + (i16n); const size_t _a0 = (size_t)__builtin_amdgcn_readlane(pp0, (i16n)) * D, _a1 = (size_t)__builtin_amdgcn_readlane(pp1, (i16n)) * D, _b0 = (size_t)__builtin_amdgcn_readlane(pp0, (i16n) + 1) * D, _b1 = (size_t)__builtin_amdgcn_readlane(pp1, (i16n) + 1) * D; \
        _Pragma("unroll") for (int j = 0; j < 4; ++j) { ha[j] = *(const v2u*)(H + (size_t)_r * D + 256 * j + 4 * lane); hb[j] = *(const v2u*)(H + (size_t)(_r + 1) * D + 256 * j + 4 * lane); } \
        _Pragma("unroll") for (int j = 0; j < 4; ++j) { ya0[j] = *(const unsigned*)(Y + _a0 + 256 * j + 4 * lane); ya1[j] = *(const unsigned*)(Y + _a1 + 256 * j + 4 * lane); yb0[j] = *(const unsigned*)(Y + _b0 + 256 * j + 4 * lane); yb1[j] = *(const unsigned*)(Y + _b1 + 256 * j + 4 * lane); } } while (0)
    COMBINE_LOAD(0);
#pragma unroll
    for (int i16 = 0; i16 < 16; i16 += 2) { const int row = rowbase + i16;
        f32x4 va[4], vb[4];
        typedef float f32x2v __attribute__((ext_vector_type(2)));
#pragma unroll
        for (int j = 0; j < 4; ++j) { const f32x2v a0l = __builtin_amdgcn_cvt_pk_f32_fp8((int)ya0[j], false), a0h = __builtin_amdgcn_cvt_pk_f32_fp8((int)ya0[j], true), a1l = __builtin_amdgcn_cvt_pk_f32_fp8((int)ya1[j], false), a1h = __builtin_amdgcn_cvt_pk_f32_fp8((int)ya1[j], true);
            const f32x2v b0l = __builtin_amdgcn_cvt_pk_f32_fp8((int)yb0[j], false), b0h = __builtin_amdgcn_cvt_pk_f32_fp8((int)yb0[j], true), b1l = __builtin_amdgcn_cvt_pk_f32_fp8((int)yb1[j], false), b1h = __builtin_amdgcn_cvt_pk_f32_fp8((int)yb1[j], true);
            va[j].x = bflo(ha[j].x) + (a0l.x + a1l.x) * 0.0625f; va[j].y = bfhi(ha[j].x) + (a0l.y + a1l.y) * 0.0625f; va[j].z = bflo(ha[j].y) + (a0h.x + a1h.x) * 0.0625f; va[j].w = bfhi(ha[j].y) + (a0h.y + a1h.y) * 0.0625f;
            vb[j].x = bflo(hb[j].x) + (b0l.x + b1l.x) * 0.0625f; vb[j].y = bfhi(hb[j].x) + (b0l.y + b1l.y) * 0.0625f; vb[j].z = bflo(hb[j].y) + (b0h.x + b1h.x) * 0.0625f; vb[j].w = bfhi(hb[j].y) + (b0h.y + b1h.y) * 0.0625f; }
        if (i16 + 2 < 16) COMBINE_LOAD(i16 + 2);
        float sa, sb; row_ssq2(va, vb, lane, sa, sb);
        const float ra = rsqrtf(sa * (1.f / D) + EPS), rb = rsqrtf(sb * (1.f / D) + EPS);
        if (MODE == 0) {
            store_row_bf16(H + (size_t)row * D, lane, va, 1.f); store_row_bf16(H + (size_t)(row + 1) * D, lane, vb, 1.f);
            if (lane == 0) { rstd[row] = ra; rstd[row + 1] = rb; }
        } else {
#pragma unroll
            for (int j = 0; j < 4; ++j) { const f32x4 g = gfin[j];
                f32x4 oa, ob; oa.x = va[j].x * ra * g.x; oa.y = va[j].y * ra * g.y; oa.z = va[j].z * ra * g.z; oa.w = va[j].w * ra * g.w; ob.x = vb[j].x * rb * g.x; ob.y = vb[j].y * rb * g.y; ob.z = vb[j].z * rb * g.z; ob.w = vb[j].w * rb * g.w;
                *(f32x4*)(out + (size_t)row * D + 256 * j + 4 * lane) = oa; *(f32x4*)(out + (size_t)(row + 1) * D + 256 * j + 4 * lane) = ob; }
        }
    }
#undef COMBINE_LOAD
}
__device__ __forceinline__ void build_tile_prefix(const unsigned* cnt, LAS int* tp) {
    if (TIDX < 64) { const int lane = TIDX; const int tiles = lane < 16 ? (((int)cnt[lane & 15] + 255) >> 8) : 0; int incl = tiles;
#pragma unroll
        for (int o = 1; o < 16; o <<= 1) { const int v = __shfl_up(incl, o); incl += (lane >= o) ? v : 0; }
        if (lane < 16) tp[lane] = incl - tiles;
        if (lane == 15) tp[16] = incl; }
    __syncthreads();
}
typedef short bf16x8 __attribute__((ext_vector_type(8)));
typedef short s16x4 __attribute__((ext_vector_type(4)));
typedef short v4i16_t __attribute__((ext_vector_type(4)));
typedef float f32x16 __attribute__((ext_vector_type(16)));
typedef float f32x2_t __attribute__((ext_vector_type(2)));
typedef __bf16 bf16x2_t __attribute__((ext_vector_type(2)));
#define MFMA32(a, b, c) __builtin_amdgcn_mfma_f32_32x32x16_bf16((a), (b), (c), 0, 0, 0)
__device__ __forceinline__ unsigned cvtpk(float lo, float hi) { f32x2_t v = {lo, hi}; return __builtin_bit_cast(unsigned, __builtin_convertvector(v, bf16x2_t)); }
__device__ __forceinline__ s16x4 vtr(const LAS unsigned char* p) { return __builtin_bit_cast(s16x4, __builtin_amdgcn_ds_read_tr16_b64_v4i16((LAS v4i16_t*)p)); }
__device__ __forceinline__ bf16x8 cat4(s16x4 a, s16x4 b) { bf16x8 r; r[0] = a[0]; r[1] = a[1]; r[2] = a[2]; r[3] = a[3]; r[4] = b[0]; r[5] = b[1]; r[6] = b[2]; r[7] = b[3]; return r; }
__device__ __forceinline__ bf16x8 pack8(const f32x16& x, int s) {
    v4u p; p.x = cvtpk(x[8 * s], x[8 * s + 1]); p.y = cvtpk(x[8 * s + 2], x[8 * s + 3]); p.z = cvtpk(x[8 * s + 4], x[8 * s + 5]); p.w = cvtpk(x[8 * s + 6], x[8 * s + 7]); return __builtin_bit_cast(bf16x8, p); }
__device__ __forceinline__ f32x16 zero16() { f32x16 z;
#pragma unroll
    for (int i = 0; i < 16; ++i) z[i] = 0.f; return z; }
#define LDSBAR() do { asm volatile("s_waitcnt lgkmcnt(0)" ::: "memory"); __builtin_amdgcn_s_barrier(); asm volatile("" ::: "memory"); } while (0)
constexpr size_t WS_DEC = 510 * MiB;
constexpr size_t WS_B = 50 * MiB;
constexpr int RS_P = 272, RS_T = 320, RS_V = 576;
typedef float f32x2g __attribute__((ext_vector_type(2)));
__device__ __forceinline__ void gla_gates(const f32x4 gk_piece, const f32x2g (&w2)[GR / 2], const float bias, LAS float* sm_gklr, LAS float* sm_qt, float (&bq)[16], float& blast) {
    const int tid = TIDX, d = tid & 127, qtr = tid >> 7;
    if (tid < 256) *(LAS f32x4*)(sm_gklr + 4 * tid) = gk_piece;
    typedef float f32x2v __attribute__((ext_vector_type(2)));
    LDSBAR();
    float run = 0.f;
#pragma unroll
    for (int i = 0; i < 16; ++i) { const int c = 16 * qtr + i; f32x2v xa = {bias, 0.f};
#pragma unroll
        for (int r4 = 0; r4 < 4; ++r4) { const f32x4 g = *(const LAS f32x4*)(sm_gklr + c * 16 + 4 * r4); const f32x2v gl = {g.x, g.y}, gh = {g.z, g.w}; xa += gl * w2[2 * r4]; xa += gh * w2[2 * r4 + 1]; }
        const float x = xa.x + xa.y;
        run += (fminf(x, 0.f) - __logf(1.f + __expf(-fabsf(x)))) * (1.f / 16.f); bq[i] = run; }
    sm_qt[qtr * 128 + d] = run;
    LDSBAR();
    float off = 0.f, tot = 0.f;
#pragma unroll
    for (int q = 0; q < 4; ++q) { const float v = sm_qt[q * 128 + d]; off += (q < qtr) ? v : 0.f; tot += v; }
#pragma unroll
    for (int i = 0; i < 16; ++i) bq[i] += off;
    blast = tot;
}
__device__ __forceinline__ void stage_v(const bf16* vsrc, LAS unsigned char* imgV) {
#pragma unroll
    for (int i = 0; i < 4; ++i) { const int ch = TIDX + 512 * i, r = ch >> 5, cc = ch & 31; *(LAS v4u*)(imgV + r * RS_V + cc * 16) = *(const v4u*)(vsrc + (size_t)r * NPROJ + cc * 8); }
}
__device__ __forceinline__ bf16x8 tr_frag(const LAS unsigned char* img, int RS, int rowA, int rowB, int col0, int lane) {
    const int q = (lane & 15) >> 2, cb = (col0 + 16 * ((lane >> 4) & 1) + 4 * (lane & 3)) * 2;
    return cat4(vtr(img + (rowA + q) * RS + cb), vtr(img + (rowB + q) * RS + cb));
}
__device__ __forceinline__ int prev_off(int row, int ch) { return row * 128 + ((ch ^ ((row >> 1) & 7)) << 4); }
__device__ __forceinline__ void gla_g3_super(const In& in, unsigned char* ws, LAS unsigned char* lds, int sunit) {
    const int unit0 = (sunit >> 4) * 64 + (sunit & 15) * 4;
    f32x16 Sacc[4];
    { const int lane_ = TIDX & 63, wave_ = TIDX >> 6, hh_ = lane_ >> 5, r_ = lane_ & 31; const bf16* prev0 = (const bf16*)(ws + WS_ST) + (size_t)sunit * (DV * DK) + (size_t)(32 * wave_ + r_) * DK;
#pragma unroll
      for (int t = 0; t < 4; ++t)
#pragma unroll
          for (int g = 0; g < 4; ++g) { const v2u pv = *(const v2u*)(prev0 + 32 * t + 8 * g + 4 * hh_); Sacc[t][4 * g] = bflo(pv.x); Sacc[t][4 * g + 1] = bfhi(pv.x); Sacc[t][4 * g + 2] = bflo(pv.y); Sacc[t][4 * g + 3] = bfhi(pv.y); } }
    typedef _Float16 h8 __attribute__((ext_vector_type(8)));
    v4u qraw[2], kraw[2], vraw[4]; h8 braw[2];
    { const int tid = TIDX, hd0 = (unit0 >> 6) & 3; const size_t row00 = (size_t)(unit0 >> 8) * SEQ + (unit0 & 63) * CH; const bf16* proj0 = (const bf16*)(ws + WS_PROJ) + row00 * NPROJ; const _Float16* bin0 = (const _Float16*)(ws + WS_B) + row00 * QKD + hd0 * DK;
#pragma unroll
      for (int i = 0; i < 2; ++i) { const int ch = tid + 512 * i, c = ch >> 4, d0 = (ch & 15) * 8; qraw[i] = *(const v4u*)(proj0 + (size_t)c * NPROJ + hd0 * DK + d0); kraw[i] = *(const v4u*)(proj0 + (size_t)c * NPROJ + QKD + hd0 * DK + d0); braw[i] = *(const h8*)(bin0 + (size_t)c * QKD + d0); }
#pragma unroll
      for (int i = 0; i < 4; ++i) { const int ch = tid + 512 * i; vraw[i] = *(const v4u*)(proj0 + 1024 + hd0 * DV + (size_t)(ch >> 5) * NPROJ + (ch & 31) * 8); } }
#pragma unroll 1
    for (int jsub = 0; jsub < 4; ++jsub) { const int unit = unit0 + jsub;
    const int tid = TIDX, lane = tid & 63, wave = tid >> 6, hh = lane >> 5, r = lane & 31, d = tid & 127, qtr = tid >> 7;
    const int n = unit & 63, hd = (unit >> 6) & 3, b = unit >> 8; const size_t row0 = (size_t)b * SEQ + n * CH;
    const bf16* proj = (const bf16*)(ws + WS_PROJ) + row0 * NPROJ;
    LAS float* sm_ssq = (LAS float*)(lds + 6144);
    LAS unsigned char* imgQ = lds + 8192; LAS unsigned char* imgK = imgQ + 64 * RS_P; LAS unsigned char* imgV = imgK + 64 * RS_P; LAS unsigned char* imgS = imgV + 64 * RS_V; LAS unsigned char* imgO = lds + 8192;
    const int ib = wave & 1, dg = wave >> 1;
    LAS float* sm_dec = (LAS float*)(lds + 4096);
    { const _Float16* bin = (const _Float16*)(ws + WS_B) + row0 * QKD + hd * DK; f32x4 b0[2], b1[2];
#pragma unroll
      for (int i = 0; i < 2; ++i) { const h8 bb = braw[i]; b0[i] = (f32x4){(float)bb[0], (float)bb[1], (float)bb[2], (float)bb[3]}; b1[i] = (f32x4){(float)bb[4], (float)bb[5], (float)bb[6], (float)bb[7]}; }
#pragma unroll
      for (int i = 0; i < 2; ++i) { const int ch = tid + 512 * i, c = ch >> 4, d0 = (ch & 15) * 8;
        const float e0 = __expf(b0[i].x), e1 = __expf(b0[i].y), e2 = __expf(b0[i].z), e3 = __expf(b0[i].w), e4 = __expf(b1[i].x), e5 = __expf(b1[i].y), e6 = __expf(b1[i].z), e7 = __expf(b1[i].w);
        v4u qo, ko; const v4u q = qraw[i], k = kraw[i];
        qo.x = cvtpk(bflo(q.x) * e0, bfhi(q.x) * e1); qo.y = cvtpk(bflo(q.y) * e2, bfhi(q.y) * e3); qo.z = cvtpk(bflo(q.z) * e4, bfhi(q.z) * e5); qo.w = cvtpk(bflo(q.w) * e6, bfhi(q.w) * e7);
        ko.x = cvtpk(bflo(k.x) * __builtin_amdgcn_rcpf(e0), bfhi(k.x) * __builtin_amdgcn_rcpf(e1)); ko.y = cvtpk(bflo(k.y) * __builtin_amdgcn_rcpf(e2), bfhi(k.y) * __builtin_amdgcn_rcpf(e3));
        ko.z = cvtpk(bflo(k.z) * __builtin_amdgcn_rcpf(e4), bfhi(k.z) * __builtin_amdgcn_rcpf(e5)); ko.w = cvtpk(bflo(k.w) * __builtin_amdgcn_rcpf(e6), bfhi(k.w) * __builtin_amdgcn_rcpf(e7));
        *(LAS v4u*)(imgQ + c * RS_P + d0 * 2) = qo; *(LAS v4u*)(imgK + c * RS_P + d0 * 2) = ko;
        if (c == 63) { *(LAS f32x4*)(sm_dec + d0) = (f32x4){e0, e1, e2, e3}; *(LAS f32x4*)(sm_dec + d0 + 4) = (f32x4){e4, e5, e6, e7}; } }
#pragma unroll
      for (int i = 0; i < 4; ++i) { const int ch = tid + 512 * i; *(LAS v4u*)(imgV + (ch >> 5) * RS_V + (ch & 31) * 16) = vraw[i]; }
      if (jsub < 3) { const bf16* projn = proj + (size_t)CH * NPROJ; const _Float16* binn = bin + (size_t)CH * QKD;
#pragma unroll
        for (int i = 0; i < 2; ++i) { const int ch = tid + 512 * i, c = ch >> 4, d0 = (ch & 15) * 8; qraw[i] = *(const v4u*)(projn + (size_t)c * NPROJ + hd * DK + d0); kraw[i] = *(const v4u*)(projn + (size_t)c * NPROJ + QKD + hd * DK + d0); braw[i] = *(const h8*)(binn + (size_t)c * QKD + d0); }
#pragma unroll
        for (int i = 0; i < 4; ++i) { const int ch = tid + 512 * i; vraw[i] = *(const v4u*)(projn + 1024 + hd * DV + (size_t)(ch >> 5) * NPROJ + (ch & 31) * 8); } } }
#pragma unroll
    for (int t = 0; t < 2; ++t)
#pragma unroll
        for (int g = 0; g < 4; ++g) { v2u o; o.x = cvtpk(Sacc[t][4 * g], Sacc[t][4 * g + 1]); o.y = cvtpk(Sacc[t][4 * g + 2], Sacc[t][4 * g + 3]); *(LAS v2u*)(imgS + prev_off(32 * wave + r, 4 * t + g) + 8 * hh) = o; }
    LDSBAR();
    bf16x8 qf[8];
#pragma unroll
    for (int s = 0; s < 8; ++s) qf[s] = *(const LAS bf16x8*)(imgQ + (32 * ib + r) * RS_P + (16 * s + 8 * hh) * 2);
    f32x16 acc[2]; acc[0] = zero16(); acc[1] = zero16();
#pragma unroll
    for (int jb = 0; jb < 2; ++jb) {
        if (jb <= ib) {
            f32x16 att = zero16();
#pragma unroll
            for (int s = 0; s < 8; ++s) { const bf16x8 A = *(const LAS bf16x8*)(imgK + (32 * jb + r) * RS_P + (16 * s + 8 * hh) * 2); att = MFMA32(A, qf[s], att); }
            if (jb == ib) {
#pragma unroll
                for (int i = 0; i < 16; ++i) { const int j = (i & 3) + 8 * (i >> 2) + 4 * hh; att[i] = (j > r) ? 0.f : att[i]; } }
#pragma unroll
            for (int s2 = 0; s2 < 2; ++s2) { const bf16x8 P = pack8(att, s2); const int ra = 32 * jb + 16 * s2 + 4 * hh, rb = ra + 8;
#pragma unroll
                for (int t = 0; t < 2; ++t) { const bf16x8 A = tr_frag(imgV, RS_V, ra, rb, 64 * dg + 32 * t, lane); acc[t] = MFMA32(A, P, acc[t]); } }
        }
    }
#pragma unroll
    for (int s = 0; s < 4; ++s)
#pragma unroll
        for (int t = 0; t < 2; ++t) { const bf16x8 A = *(const LAS bf16x8*)(imgS + prev_off(64 * dg + 32 * t + r, 2 * s + hh)); acc[t] = MFMA32(A, qf[s], acc[t]); }
    LDSBAR();
#pragma unroll
    for (int t = 0; t < 2; ++t)
#pragma unroll
        for (int g = 0; g < 4; ++g) { v2u o; o.x = cvtpk(Sacc[2 + t][4 * g], Sacc[2 + t][4 * g + 1]); o.y = cvtpk(Sacc[2 + t][4 * g + 2], Sacc[2 + t][4 * g + 3]); *(LAS v2u*)(imgS + prev_off(32 * wave + r, 4 * t + g) + 8 * hh) = o; }
    LDSBAR();
#pragma unroll
    for (int s = 0; s < 4; ++s)
#pragma unroll
        for (int t = 0; t < 2; ++t) { const bf16x8 A = *(const LAS bf16x8*)(imgS + prev_off(64 * dg + 32 * t + r, 2 * s + hh)); acc[t] = MFMA32(A, qf[4 + s], acc[t]); }
    v4u graw[4];
#pragma unroll
    for (int i = 0; i < 4; ++i) { const int ch = tid + 512 * i; graw[i] = *(const v4u*)(proj + 2048 + hd * DV + (size_t)(ch >> 5) * NPROJ + (ch & 31) * 8); }
#pragma unroll
    for (int s = 0; s < 4; ++s) { const int ra = 16 * s + 8 * hh, rb = ra + 4; const bf16x8 Bv = tr_frag(imgV, RS_V, ra, rb, 32 * wave, lane);
#pragma unroll
        for (int t = 0; t < 4; ++t) Sacc[t] = MFMA32(tr_frag(imgK, RS_P, ra, rb, 32 * t, lane), Bv, Sacc[t]); }
#pragma unroll
    for (int t = 0; t < 4; ++t)
#pragma unroll
        for (int i = 0; i < 16; ++i) Sacc[t][i] *= sm_dec[32 * t + (i & 3) + 8 * (i >> 2) + 4 * hh];
    float ssq = 0.f;
#pragma unroll
    for (int t = 0; t < 2; ++t)
#pragma unroll
        for (int i = 0; i < 16; ++i) ssq += acc[t][i] * acc[t][i];
    ssq += __shfl_xor(ssq, 32);
    if (hh == 0) sm_ssq[(ib * 4 + dg) * 32 + r] = ssq;
    LDSBAR();
    const float tot = (sm_ssq[(ib * 4 + 0) * 32 + r] + sm_ssq[(ib * 4 + 1) * 32 + r]) + (sm_ssq[(ib * 4 + 2) * 32 + r] + sm_ssq[(ib * 4 + 3) * 32 + r]);
    const float rstd = rsqrtf(tot * (1.f / DV) + EPS);
#pragma unroll
    for (int t = 0; t < 2; ++t)
#pragma unroll
        for (int g = 0; g < 4; ++g) { v2u o; o.x = cvtpk(acc[t][4 * g] * rstd, acc[t][4 * g + 1] * rstd); o.y = cvtpk(acc[t][4 * g + 2] * rstd, acc[t][4 * g + 3] * rstd);
            *(LAS v2u*)(imgO + (32 * ib + r) * 520 + (64 * dg + 32 * t + 8 * g + 4 * hh) * 2) = o; }
    LDSBAR();
    bf16* og = (bf16*)(ws + WS_U) + row0 * D + hd * DV;
#pragma unroll
    for (int i = 0; i < 4; ++i) { const int ch = tid + 512 * i, row = ch >> 5, cc = ch & 31;
        const v2u a = *(const LAS v2u*)(imgO + row * 520 + cc * 16), b2 = *(const LAS v2u*)(imgO + row * 520 + cc * 16 + 8);
        const v4u gg = graw[i];
        v4u o; o.x = cvtpk(bflo(a.x) * pg8::silu_f(bflo(gg.x)), bfhi(a.x) * pg8::silu_f(bfhi(gg.x))); o.y = cvtpk(bflo(a.y) * pg8::silu_f(bflo(gg.y)), bfhi(a.y) * pg8::silu_f(bfhi(gg.y)));
        o.z = cvtpk(bflo(b2.x) * pg8::silu_f(bflo(gg.z)), bfhi(b2.x) * pg8::silu_f(bfhi(gg.z))); o.w = cvtpk(bflo(b2.y) * pg8::silu_f(bflo(gg.w)), bfhi(b2.y) * pg8::silu_f(bfhi(gg.w)));
        *(v4u*)(og + (size_t)row * D + cc * 8) = o; }
    LDSBAR();
    }
}

__device__ __forceinline__ void gla_g1_super(const In& in, unsigned char* ws, LAS unsigned char* lds, int sunit) {
    const int tid = TIDX, lane = tid & 63, wave = tid >> 6, hh = lane >> 5, r = lane & 31, d = tid & 127, qtr = tid >> 7;
    const int unit0 = (sunit >> 4) * 64 + (sunit & 15) * 4; const int mb = wave & 3, ng = wave >> 2;
    LAS float* sm_dec = (LAS float*)(lds + 6144);
    f32x16 acc[4];
#pragma unroll
    for (int t = 0; t < 4; ++t) acc[t] = zero16();
    float decprod = 1.f;
    unsigned short kraw[16]; v4u vraw[4]; f32x4 gkp = {0.f, 0.f, 0.f, 0.f}; f32x2g w2[GR / 2]; float bias;
    { const int hd0 = (unit0 >> 6) & 3; const size_t row00 = (size_t)(unit0 >> 8) * SEQ + (unit0 & 63) * CH; const bf16* proj0 = (const bf16*)(ws + WS_PROJ) + row00 * NPROJ;
      if (tid < 256) gkp = *(const f32x4*)((const float*)(ws + WS_GKLR) + row00 * 16 + 4 * tid);
#pragma unroll
      for (int i = 0; i < 16; ++i) kraw[i] = proj0[(size_t)(16 * qtr + i) * NPROJ + QKD + hd0 * DK + d];
#pragma unroll
      for (int i = 0; i < 4; ++i) { const int ch = tid + 512 * i; vraw[i] = *(const v4u*)(proj0 + 1024 + hd0 * DV + (size_t)(ch >> 5) * NPROJ + (ch & 31) * 8); }
#pragma unroll
      for (int r = 0; r < GR / 2; ++r) { w2[r].x = in.a_w_gk2[(2 * r) * QKD + hd0 * DK + d]; w2[r].y = in.a_w_gk2[(2 * r + 1) * QKD + hd0 * DK + d]; }
      bias = in.a_b_gk2[hd0 * DK + d]; }
#pragma unroll 1
    for (int jsub = 0; jsub < 4; ++jsub) { const int unit = unit0 + jsub;
    const int n = unit & 63, hd = (unit >> 6) & 3, b = unit >> 8; const size_t row0 = (size_t)b * SEQ + n * CH;
    const bf16* proj = (const bf16*)(ws + WS_PROJ) + row0 * NPROJ;
    LAS float* sm_gklr = (LAS float*)lds; LAS float* sm_qt = (LAS float*)(lds + 4096); LAS unsigned char* imgK = lds + 8192; LAS unsigned char* imgV = lds + 8192 + 64 * RS_T;
    float bq[16], blast; gla_gates(gkp, w2, bias, sm_gklr, sm_qt, bq, blast);
    _Float16* bout = (_Float16*)(ws + WS_B) + row0 * QKD + hd * DK + d;
#pragma unroll
    for (int i = 0; i < 16; ++i) { const int c = 16 * qtr + i; bout[(size_t)c * QKD] = (_Float16)bq[i]; *(LAS unsigned short*)(imgK + c * RS_T + d * 2) = (unsigned short)f2bf(bf2f(kraw[i]) * __expf(blast - bq[i])); }
    if (qtr == 0) { const float dj = __expf(blast); sm_dec[d] = dj; decprod *= dj; }
#pragma unroll
    for (int i = 0; i < 4; ++i) { const int ch = tid + 512 * i; *(LAS v4u*)(imgV + (ch >> 5) * RS_V + (ch & 31) * 16) = vraw[i]; }
    if (jsub < 3) { const bf16* projn = proj + (size_t)CH * NPROJ;
      if (tid < 256) gkp = *(const f32x4*)((const float*)(ws + WS_GKLR) + (row0 + CH) * 16 + 4 * tid);
#pragma unroll
      for (int i = 0; i < 16; ++i) kraw[i] = projn[(size_t)(16 * qtr + i) * NPROJ + QKD + hd * DK + d];
#pragma unroll
      for (int i = 0; i < 4; ++i) { const int ch = tid + 512 * i; vraw[i] = *(const v4u*)(projn + 1024 + hd * DV + (size_t)(ch >> 5) * NPROJ + (ch & 31) * 8); } }
    LDSBAR();
#pragma unroll
    for (int t = 0; t < 4; ++t)
#pragma unroll
        for (int i = 0; i < 16; ++i) acc[t][i] *= sm_dec[32 * mb + (i & 3) + 8 * (i >> 2) + 4 * hh];
#pragma unroll
    for (int s = 0; s < 4; ++s) { const int ra = 16 * s + 8 * hh, rb = ra + 4;
        const bf16x8 A = tr_frag(imgK, RS_T, ra, rb, 32 * mb, lane);
#pragma unroll
        for (int t = 0; t < 4; ++t) { const bf16x8 B = tr_frag(imgV, RS_V, ra, rb, 32 * (4 * ng + t), lane); acc[t] = MFMA32(A, B, acc[t]); } }
    LDSBAR();
    }
    LAS unsigned char* imgO = lds + 8192;
#pragma unroll
    for (int t = 0; t < 4; ++t) { const int dv = 32 * (4 * ng + t) + r;
#pragma unroll
        for (int g = 0; g < 4; ++g) { v2u o; o.x = cvtpk(acc[t][4 * g], acc[t][4 * g + 1]); o.y = cvtpk(acc[t][4 * g + 2], acc[t][4 * g + 3]); *(LAS v2u*)(imgO + dv * 264 + (32 * mb + 8 * g + 4 * hh) * 2) = o; } }
    LDSBAR();
    bf16* upd = (bf16*)(ws + WS_ST) + (size_t)sunit * (DV * DK);
    if (qtr == 0) ((float*)(ws + WS_DEC))[(size_t)sunit * DK + d] = decprod;
#pragma unroll
    for (int i = 0; i < 8; ++i) { const int ch = tid + 512 * i, row = ch >> 4, cc = ch & 15; v2u a = *(const LAS v2u*)(imgO + row * 264 + cc * 16), b2 = *(const LAS v2u*)(imgO + row * 264 + cc * 16 + 8);
        v4u o; o.x = a.x; o.y = a.y; o.z = b2.x; o.w = b2.y; *(v4u*)(upd + (size_t)row * DK + cc * 8) = o; }
    LDSBAR();
}

__device__ __forceinline__ void gla_g2_super(unsigned char* ws, LAS float* sdec) {
    const int tid = TIDX, gid = blockIdx.x * 512 + tid;
    const int bh = (blockIdx.x * 512) >> 12, e8 = gid & 4095, dk0 = (e8 * 8) & 127;
    { const float* dsrc = (const float*)(ws + WS_DEC) + (size_t)bh * 16 * DK;
      *(LAS f32x4*)(sdec + 4 * tid) = *(const f32x4*)(dsrc + 4 * tid); }
    LDSBAR();
    bf16* base = (bf16*)(ws + WS_ST) + (size_t)bh * 16 * (DV * DK) + e8 * 8;
    float S[8];
#pragma unroll
    for (int j = 0; j < 8; ++j) S[j] = 0.f;
    for (int n0 = 0; n0 < NCH / 4; n0 += 16) {
        v4u u[16];
#pragma unroll
        for (int i = 0; i < 16; ++i) u[i] = *(const v4u*)(base + (size_t)(n0 + i) * (DV * DK));
#pragma unroll
        for (int i = 0; i < 16; ++i) { const f32x4 da = *(const LAS f32x4*)(sdec + (n0 + i) * DK + dk0), db = *(const LAS f32x4*)(sdec + (n0 + i) * DK + dk0 + 4);
            v4u o; o.x = cvtpk(S[0], S[1]); o.y = cvtpk(S[2], S[3]); o.z = cvtpk(S[4], S[5]); o.w = cvtpk(S[6], S[7]); *(v4u*)(base + (size_t)(n0 + i) * (DV * DK)) = o;
            S[0] = da.x * S[0] + bflo(u[i].x); S[1] = da.y * S[1] + bfhi(u[i].x); S[2] = da.z * S[2] + bflo(u[i].y); S[3] = da.w * S[3] + bfhi(u[i].y);
            S[4] = db.x * S[4] + bflo(u[i].z); S[5] = db.y * S[5] + bfhi(u[i].z); S[6] = db.z * S[6] + bflo(u[i].w); S[7] = db.w * S[7] + bfhi(u[i].w); }
    }
}
constexpr int RS_SV = 192, RS_SK = 144, SB_WAVE_LDS = 32 * RS_SV + 32 * RS_SK;
__device__ __forceinline__ float softplus_fast(float z) { return fmaxf(z, 0.f) + __logf(1.f + __expf(-fabsf(z))); }
__device__ __forceinline__ bool sb_block(LAS unsigned char* imgK, LAS unsigned char* imgV, const bf16x8 (&qf)[4], const v4u (&kv)[4], const v4u (&vv)[4], f32x16& o0, f32x16& o1, float& R, float& carry, bool diag, int lane) {
    const int hh = lane >> 5, r = lane & 31, lrow = lane >> 3, lch = lane & 7;
#pragma unroll
    for (int s = 0; s < 4; ++s) { *(LAS v4u*)(imgK + (8 * s + lrow) * RS_SK + lch * 16) = kv[s]; *(LAS v4u*)(imgV + (8 * s + lrow) * RS_SV + lch * 16) = vv[s]; }
    bf16x8 kf[4];
#pragma unroll
    for (int s = 0; s < 4; ++s) kf[s] = *(const LAS bf16x8*)(imgK + r * RS_SK + 64 * hh + 16 * s);
    f32x16 z = zero16();
#pragma unroll
    for (int s = 0; s < 4; ++s) z = MFMA32(kf[s], qf[s], z);
    float om[16], be[16];
    if (diag) {
#pragma unroll
        for (int i = 0; i < 16; ++i) { const int keyl = (i & 3) + 8 * (i >> 2) + 4 * hh; const float o_ = __builtin_amdgcn_rcpf(1.f + __builtin_amdgcn_exp2f(z[i])); const bool valid = keyl < r; om[i] = valid ? o_ : 1.f; be[i] = valid ? 1.f - o_ : 0.f; }
    } else {
#pragma unroll
        for (int i = 0; i < 16; ++i) { om[i] = __builtin_amdgcn_rcpf(1.f + __builtin_amdgcn_exp2f(z[i])); be[i] = 1.f - om[i]; }
    }
    float pr[4], Tg[4];
#pragma unroll
    for (int g = 0; g < 4; ++g) { const float rg = (om[4 * g] * om[4 * g + 1]) * (om[4 * g + 2] * om[4 * g + 3]); pr[g] = __shfl_xor(rg, 32); Tg[g] = rg * pr[g]; }
    float off[4]; off[3] = carry; off[2] = carry * Tg[3]; off[1] = off[2] * Tg[2]; off[0] = off[1] * Tg[1];
    if (hh == 0) {
#pragma unroll
        for (int g = 0; g < 4; ++g) off[g] *= pr[g]; }
    f32x16 a;
#pragma unroll
    for (int g = 0; g < 4; ++g) { const float w2 = om[4 * g + 3], w1 = w2 * om[4 * g + 2], w0 = w1 * om[4 * g + 1];
        a[4 * g] = be[4 * g] * (off[g] * w0); a[4 * g + 1] = be[4 * g + 1] * (off[g] * w1); a[4 * g + 2] = be[4 * g + 2] * (off[g] * w2); a[4 * g + 3] = be[4 * g + 3] * off[g]; }
    R -= __builtin_amdgcn_logf((Tg[0] * Tg[1]) * (Tg[2] * Tg[3]));
    carry = __builtin_amdgcn_exp2f(-R);
#pragma unroll
    for (int s2 = 0; s2 < 2; ++s2) { const bf16x8 P = pack8(a, s2); const int ra = 16 * s2 + 4 * hh, rb = ra + 8;
        o0 = MFMA32(tr_frag(imgV, RS_SV, ra, rb, 0, lane), P, o0); o1 = MFMA32(tr_frag(imgV, RS_SV, ra, rb, 32, lane), P, o1); }
    return __all(R > 150.5f);
}
__device__ __forceinline__ void sb_load_kv(const bf16* base, int kb, int lane, v4u (&kv)[4], v4u (&vv)[4]) {
    const bf16* kp = base + 1024 + (size_t)(kb * 32 + (lane >> 3)) * NPROJ + (lane & 7) * 8;
#pragma unroll
    for (int s = 0; s < 4; ++s) { kv[s] = *(const v4u*)(kp + (size_t)(8 * s) * NPROJ); vv[s] = *(const v4u*)(kp + 1024 + (size_t)(8 * s) * NPROJ); }
}
__device__ __forceinline__ void sb_attn_task(unsigned char* ws, LAS unsigned char* imgV, int task, int lane) {
    LAS unsigned char* imgK = imgV + 32 * RS_SV;
    const int hh = lane >> 5, r = lane & 31, qb = task & 127, bh = task >> 7, hd = bh & 15, b = bh >> 4, lrow = lane >> 3, lch = lane & 7;
    const bf16* base = (const bf16*)(ws + WS_PROJ) + (size_t)b * SEQ * NPROJ + hd * SBD;
    bf16x8 qf[4];
    { const bf16* qrow = base + (size_t)(qb * 32 + r) * NPROJ + 32 * hh;
#pragma unroll
      for (int s = 0; s < 4; ++s) qf[s] = *(const bf16x8*)(qrow + 8 * s); }
    f32x16 o0 = zero16(), o1 = zero16(); float R = 0.f, carry = 1.f;
    v4u ka[4], va[4], kb4[4], vb4[4];
    sb_load_kv(base, qb, lane, ka, va);
    for (int kb = qb;;) {
        sb_load_kv(base, kb > 0 ? kb - 1 : 0, lane, kb4, vb4);
        if (sb_block(imgK, imgV, qf, ka, va, o0, o1, R, carry, kb == qb, lane) || kb == 0) break;
        --kb;
        sb_load_kv(base, kb > 0 ? kb - 1 : 0, lane, ka, va);
        if (sb_block(imgK, imgV, qf, kb4, vb4, o0, o1, R, carry, false, lane) || kb == 0) break;
        --kb;
    }
#pragma unroll
    for (int g = 0; g < 4; ++g) { v2u w; w.x = cvtpk(o0[4 * g], o0[4 * g + 1]); w.y = cvtpk(o0[4 * g + 2], o0[4 * g + 3]); *(LAS v2u*)(imgK + r * RS_SK + (8 * g + 4 * hh) * 2) = w;
        v2u w2; w2.x = cvtpk(o1[4 * g], o1[4 * g + 1]); w2.y = cvtpk(o1[4 * g + 2], o1[4 * g + 3]); *(LAS v2u*)(imgK + r * RS_SK + (32 + 8 * g + 4 * hh) * 2) = w2; }
    bf16* obase = (bf16*)(ws + WS_U) + ((size_t)b * SEQ + qb * 32) * D + hd * SBD;
#pragma unroll
    for (int s = 0; s < 4; ++s) { const int row = 8 * s + lrow; const v2u a = *(const LAS v2u*)(imgK + row * RS_SK + lch * 16), b2 = *(const LAS v2u*)(imgK + row * RS_SK + lch * 16 + 8);
        v4u o; o.x = a.x; o.y = a.y; o.z = b2.x; o.w = b2.y; *(v4u*)(obase + (size_t)row * D + lch * 8) = o; }
}
#define XB_TMO      128
#define XB_XCNT(j)  (256  + 64 * (j))
#define XB_XSUB(j)  (1280 + 64 * (j))
#define XB_XGEN(j)  (2304 + 64 * (j))
#define XB_TOP      3328
#define XB_TOPGEN   3392
#define XCD_BAR_WORDS 3456
#define XB_SPIN_CAP (1u << 18)

__device__ __forceinline__ unsigned xb_ld(unsigned* p)              { return __hip_atomic_load(p, __ATOMIC_RELAXED, __HIP_MEMORY_SCOPE_AGENT); }
__device__ __forceinline__ unsigned xb_add(unsigned* p, unsigned v) { return __hip_atomic_fetch_add(p, v, __ATOMIC_RELAXED, __HIP_MEMORY_SCOPE_AGENT); }
__device__ __forceinline__ unsigned xb_xcc_id() { return (unsigned)__builtin_amdgcn_s_getreg((3 << 11) | 20) & 0xFu; }
#define XB_SPIN(cond, bar) do { unsigned _sp = 0; while (cond) { __builtin_amdgcn_s_sleep(1); \
    if ((++_sp & 255u) == 0u) { if (xb_ld(&(bar)[XB_TMO])) break; if (_sp > XB_SPIN_CAP) { atomicAdd(&(bar)[XB_TMO], 1u); break; } } } } while (0)

struct XcdBarrier {
    unsigned* bar; unsigned x;
    volatile LAS unsigned* st;
};

__device__ __forceinline__ XcdBarrier xcd_barrier_post(unsigned* bar, volatile LAS unsigned* st) {
    XcdBarrier b; b.bar = bar; b.x = xb_xcc_id(); b.st = st;
    if (threadIdx.x == 0) (void)xb_add(&bar[XB_XCNT(b.x)], 1u);
    return b;
}
__device__ __forceinline__ void xcd_barrier_complete(unsigned* bar, unsigned x, unsigned& nloc, unsigned& nx) {
    const unsigned G = gridDim.x * gridDim.y * gridDim.z;
    unsigned sum, cnt, mine, sp = 0u;
    for (;;) {
        sum = 0u; cnt = 0u; mine = 0u;
#pragma unroll
        for (unsigned j = 0; j < 16; ++j) { const unsigned c = xb_ld(&bar[XB_XCNT(j)]); sum += c; cnt += (c > 0u) ? 1u : 0u; mine = (j == x) ? c : mine; }
        if (sum == G) break;
        __builtin_amdgcn_s_sleep(1);
        if ((++sp & 255u) == 0u) { if (xb_ld(&bar[XB_TMO])) break; if (sp > XB_SPIN_CAP) { atomicAdd(&bar[XB_TMO], 1u); break; } }
    }
    nloc = mine > 0u ? mine : 1u; nx = cnt > 0u ? cnt : 1u;
}

__device__ __forceinline__ void xcd_barrier(const XcdBarrier& b) {
    asm volatile("s_waitcnt vmcnt(0)" ::: "memory");
    __syncthreads();
    if (threadIdx.x == 0) {
        unsigned* bar = b.bar;
        __builtin_amdgcn_s_waitcnt(0);
        unsigned nloc = b.st[0], nx = b.st[1];
        if (nloc == 0u) { xcd_barrier_complete(bar, b.x, nloc, nx); b.st[0] = nloc; b.st[1] = nx; }
        const unsigned old = xb_add(&bar[XB_XSUB(b.x)], 1u);
        const unsigned gen = old / nloc;
        if (old + 1u == (gen + 1u) * nloc) {
            __builtin_amdgcn_fence(__ATOMIC_RELEASE, "agent");
            asm volatile("s_waitcnt vmcnt(0)" ::: "memory");
            const unsigned og = xb_add(&bar[XB_TOP], 1u);
            const unsigned tg = og / nx;
            if (og + 1u == (tg + 1u) * nx) xb_add(&bar[XB_TOPGEN], 1u);
            else XB_SPIN(xb_ld(&bar[XB_TOPGEN]) == tg, bar);
            __builtin_amdgcn_fence(__ATOMIC_ACQUIRE, "agent");
            xb_add(&bar[XB_XGEN(b.x)], 1u);
            asm volatile("s_waitcnt vmcnt(0)" ::: "memory");
        } else {
            XB_SPIN(xb_ld(&bar[XB_XGEN(b.x)]) == gen, bar);
            __builtin_amdgcn_fence(__ATOMIC_ACQUIRE, "agent");
            asm volatile("s_waitcnt vmcnt(0)" ::: "memory");
        }
    }
    __syncthreads();
}
constexpr int LDS_BYTES = 147456, MISC_OFF = 131072 + 320;
struct Args { In in; float* out; unsigned char* ws; int lo, hi; };
constexpr int NPH = 19;
__global__ void __launch_bounds__(512, 2) mk_fwd(Args a) {
    extern __shared__ __attribute__((aligned(16))) unsigned char lds_raw[];
    LAS unsigned char* lds = (LAS unsigned char*)lds_raw;
    volatile LAS unsigned* MISC = (volatile LAS unsigned*)(lds + MISC_OFF);
    const int tid = threadIdx.x, lane = tid & 63, wave = __builtin_amdgcn_readfirstlane(tid >> 6);
    unsigned char* ws = a.ws; unsigned* ctl = (unsigned*)(ws + WS_CTL);
    for (int u = tid; u < (LDS_BYTES - 131072) / 4; u += 512) ((LAS unsigned*)(lds + 131072))[u] = 0u;
    __syncthreads();
    const int lo = a.lo, hi = a.hi; const bool multi = (hi - lo) > 1;
    XcdBarrier bar; bar.bar = ctl + CW_BAR; bar.x = 0; bar.st = nullptr;
    if (multi) bar = xcd_barrier_post(ctl + CW_BAR, MISC + 8);
    const bf16* WIN = (const bf16*)(ws + WS_WIN); const bf16* WAO = (const bf16*)(ws + WS_WAO); const bf16* WQKV = (const bf16*)(ws + WS_WQKV); const bf16* WBO = (const bf16*)(ws + WS_WBO);
    bf16* PROJ = (bf16*)(ws + WS_PROJ); bf16* U = (bf16*)(ws + WS_U); bf16* H = (bf16*)(ws + WS_H);
#ifndef PROBE_ID
#define PROBE_ID -1
#endif
#define PHASE(id, ...) do { if (lo <= (id) && (id) < hi) { __VA_ARGS__ if ((id) == PROBE_ID) { __syncthreads(); __VA_ARGS__ } if ((id) + 1 < hi) xcd_barrier(bar); } } while (0)
#define GEMM_B(id, W, RF32, R) PHASE(id, { pg8::Gemm g{U, W, T, D, D}; pg8::StaticOrder S; S.init(T, D, gridDim.x, blockIdx.x); pg8::EpiResBf16<RF32> E{H, R, D}; \
            pg8::gemm_phase<pg8::EpiResBf16<RF32>, pg8::StaticOrder, true, true>(lds, g, S, E); })
#define MOE(id0, layer) do { \
        PHASE((id0), { ph_router(a.in, ws, H, layer, lds); }); \
        PHASE((id0) + 1, { ph_positions(ws, layer, (LAS int*)lds); }); \
        PHASE((id0) + 2, { LAS int* tp = (LAS int*)(lds + 131072); build_tile_prefix(ctl + CW_CNT + 64 * layer, tp); \
            pg8::Gemm g{(const bf16*)(ws + WS_H8), (const bf16*)(ws + WS_W1 + (size_t)layer * 16 * 1024 * D), XROWS, 1024, D / 2}; pg8::MoeOrder S{tp, (int)gridDim.x, (int)blockIdx.x}; pg8::EpiSwiGLU8 E{ws + WS_HDN, DE, 4}; \
            pg8::gemm_phase_gather<pg8::EpiSwiGLU8, pg8::MoeOrder, true, 124, 124>(lds, g, (const unsigned*)(ws + WS_ROWOFF), (LAS unsigned*)(lds + 131072 + 1024), S, E); }); \
        PHASE((id0) + 3, { LAS int* tp = (LAS int*)(lds + 131072); build_tile_prefix(ctl + CW_CNT + 64 * layer, tp); \
            pg8::Gemm g{(const bf16*)(ws + WS_HDN), (const bf16*)(ws + WS_W2 + (size_t)layer * 16 * 1024 * DE), XROWS, 1024, DE / 2}; pg8::MoeOrder S{tp, (int)gridDim.x, (int)blockIdx.x}; pg8::EpiScaleRows8 E{ws + WS_Y, D, 4, (const float*)(ws + WS_RS2), (const LAS float*)(lds + 131072 + 2048)}; \
            pg8::gemm_phase_gather<pg8::EpiScaleRows8, pg8::MoeOrder, true, 124, 124>(lds, g, (const unsigned*)(ws + WS_ROWID), (LAS unsigned*)(lds + 131072 + 1024), S, E); }); \
        PHASE((id0) + 4, { ph_combine(a.in, ws, a.out, layer); }); } while (0)
    PHASE(0, { LAS float* scr = (LAS float*)(lds + wave * (64 * 33 * 4));
        prologue_items(a.in, ws, scr, blockIdx.x * 8 + wave, gridDim.x * 8, lane, 0, IT_WIN);
        __syncthreads();
        ph_norm_in(a.in, ws, (LAS float*)lds); });
    PHASE(1, { const int ngw = gridDim.x * 8, q = (int)(blockIdx.x >> 3) & 3;
            pg8::Gemm g{U, WIN, T, NPROJ, D}; pg8::StaticOrder S0; S0.init(T, NPROJ, gridDim.x, blockIdx.x); pg8::EpiBf16Plain E{PROJ, NPROJ, NPROJ / 256};
            { pg8::RangeOrder S{S0, 0, 2 * q}; pg8::gemm_phase<pg8::EpiBf16Plain, pg8::RangeOrder, true, true>(lds, g, S, E); }
            __syncthreads();
            { LAS float* scr = (LAS float*)(lds + wave * (64 * 33 * 4)); prologue_items(a.in, ws, scr, blockIdx.x * 8 + wave, ngw, lane, IT_WIN, IT_TOTAL); }
            __syncthreads();
            { pg8::RangeOrder S{S0, 2 * q, 1 << 20}; pg8::gemm_phase<pg8::EpiBf16Plain, pg8::RangeOrder, true, true>(lds, g, S, E); } });
    PHASE(2, { for (int u = blockIdx.x; u < BATCH * GH * (NCH / 4); u += gridDim.x) gla_g1_super(a.in, ws, lds, u); });
    PHASE(3, { gla_g2_super(ws, (LAS float*)lds); });
    PHASE(4, { for (int u = blockIdx.x; u < BATCH * GH * (NCH / 4); u += gridDim.x) gla_g3_super(a.in, ws, lds, u); });
    GEMM_B(5, WAO, true, (const void*)a.in.x);
    MOE(6, 0);
    PHASE(11, { pg8::Gemm g{H, WQKV, T, NPROJ, D}; pg8::StaticOrder S; S.init(T, NPROJ, gridDim.x, blockIdx.x); pg8::EpiScaleRows E{PROJ, NPROJ, NPROJ / 256, (const float*)(ws + WS_RSTD), (const LAS float*)(lds + 131072 + 2048)};
            pg8::gemm_phase<pg8::EpiScaleRows, pg8::StaticOrder, true, true>(lds, g, S, E); });
    PHASE(12, { for (int task = blockIdx.x * 8 + wave; task < BATCH * SBH * (SEQ / 32); task += gridDim.x * 8) sb_attn_task(ws, lds + wave * SB_WAVE_LDS, task, lane); });
    GEMM_B(13, WBO, false, (const void*)H);
    MOE(14, 1);
}
#ifndef MK_PER_PHASE
#define MK_PER_PHASE 0
#endif
extern "C" void kernel_launch(void* const* d_in, const int* in_sizes, int n_in, void* d_out, int out_size, void* d_ws, size_t ws_size, hipStream_t stream) {
    static int grid = 0;
    if (grid == 0) {
        if (n_in != 21 || in_sizes[0] != T * D || out_size != T * D || ws_size < WS_END) { fprintf(stderr, "kernel_launch: unexpected shapes (n_in %d, in0 %d, out %d, ws %zu); nothing launched\n", n_in, n_in > 0 ? in_sizes[0] : -1, out_size, ws_size); grid = -1; return; }
        int dev = 0, cus = 0, per_cu = 0;
        if (hipGetDevice(&dev) != hipSuccess || hipDeviceGetAttribute(&cus, hipDeviceAttributeMultiprocessorCount, dev) != hipSuccess) { grid = -1; return; }
        if (hipFuncSetAttribute((const void*)mk_fwd, hipFuncAttributeMaxDynamicSharedMemorySize, LDS_BYTES) != hipSuccess) { fprintf(stderr, "kernel_launch: hipFuncSetAttribute failed\n"); grid = -1; return; }
        if (hipOccupancyMaxActiveBlocksPerMultiprocessor(&per_cu, (const void*)mk_fwd, 512, LDS_BYTES) != hipSuccess || per_cu < 1) { fprintf(stderr, "kernel_launch: occupancy query says %d\n", per_cu); (void)hipGetLastError(); grid = -1; return; }
        if (cus < 256) { fprintf(stderr, "kernel_launch: this kernel needs 256 CUs (one resident workgroup each); device has %d\n", cus); grid = -1; return; }
        grid = 256;
    }
    if (grid < 0) return;
    (void)hipMemsetAsync((unsigned char*)d_ws + WS_CTL, 0, CTL_ZERO_BYTES, stream);
    Args a{}; { const float** p = (const float**)&a.in; for (int i = 0; i < 21; ++i) p[i] = (const float*)d_in[i]; }
    a.out = (float*)d_out; a.ws = (unsigned char*)d_ws;
#if MK_PER_PHASE
    for (int p = 0; p < NPH; ++p) { a.lo = p; a.hi = p + 1; hipLaunchKernelGGL(mk_fwd, dim3(grid), dim3(512), LDS_BYTES, stream, a); }
#else
    a.lo = 0; a.hi = NPH; hipLaunchKernelGGL(mk_fwd, dim3(grid), dim3(512), LDS_BYTES, stream, a);
#endif
}
```
